# Optimizing an MI355X kernel written in HIP

```python
import math
import jax, jax.numpy as jnp
from jax import lax
import numpy as np

D_MODEL = 1024
BATCH = 16
SEQ = 4096
DEPTH = 1

MLA_HEADS = 4
MLA_NOPE = 128
MLA_ROPE = 64
MLA_V = 128
Q_LORA = D_MODEL // 4
KV_LORA = D_MODEL // 8
MLA_QK = MLA_NOPE + MLA_ROPE
MLA_WIDTH = MLA_HEADS * MLA_V

DIFF_HEADS = 4
DIFF_D = 64
DIFF_V = 2 * DIFF_D
DIFF_QK_WIDTH = DIFF_HEADS * 2 * DIFF_D
DIFF_WIDTH = DIFF_HEADS * DIFF_V

MIX_WIDTH = MLA_WIDTH + DIFF_WIDTH
IN_WIDTH = Q_LORA + KV_LORA + MLA_ROPE + 2 * DIFF_QK_WIDTH + DIFF_WIDTH
SPLITS = (Q_LORA, Q_LORA + KV_LORA, Q_LORA + KV_LORA + MLA_ROPE,
          Q_LORA + KV_LORA + MLA_ROPE + DIFF_QK_WIDTH,
          Q_LORA + KV_LORA + MLA_ROPE + 2 * DIFF_QK_WIDTH)

D_FF = 4 * D_MODEL
N_BUCKETS = 32
MAX_DISTANCE = 128
ROPE_THETA = 10000.0
EPS = 1e-6
Q_BLOCK = 128

kernel_name = "hybrid_mla_diffattn_encoder_layer"


def _rmsnorm(x, w):
    x32 = x.astype(jnp.float32)
    y = x32 * lax.rsqrt(jnp.mean(x32 * x32, axis=-1, keepdims=True) + EPS)
    return (y * w.astype(jnp.float32)).astype(x.dtype)


def _rotate_half(x):
    x1, x2 = jnp.split(x, 2, axis=-1)
    return jnp.concatenate([-x2, x1], axis=-1)


def _rope_tables(seq, dtype):
    inv = ROPE_THETA ** (-jnp.arange(0, MLA_ROPE, 2, dtype=jnp.float32) / MLA_ROPE)
    ang = jnp.arange(seq, dtype=jnp.float32)[:, None] * inv[None, :]
    ang = jnp.concatenate([ang, ang], axis=-1)
    return jnp.cos(ang).astype(dtype), jnp.sin(ang).astype(dtype)


def _t5_bucket(rel):
    half = N_BUCKETS // 2
    ret = jnp.where(rel > 0, half, 0)
    n = jnp.abs(rel)
    max_exact = half // 2
    large = max_exact + (jnp.log(jnp.maximum(n, 1).astype(jnp.float32) / max_exact)
                         / math.log(MAX_DISTANCE / max_exact)
                         * (half - max_exact)).astype(jnp.int32)
    large = jnp.minimum(large, half - 1)
    return ret + jnp.where(n < max_exact, n, large)


def _query_blocks(q):
    b, s = q.shape[:2]
    qb = q.reshape((b, s // Q_BLOCK, Q_BLOCK) + q.shape[2:])
    return jnp.moveaxis(qb, 1, 0)


def _merge_blocks(o):
    o = jnp.moveaxis(o, 0, 1)
    return o.reshape((o.shape[0], o.shape[1] * o.shape[2]) + o.shape[3:])


def _mla_attention(q, k, v):
    scale = MLA_QK ** -0.5

    def one(qblk):
        s = jnp.einsum('bqhd,bkhd->bhqk', qblk, k).astype(jnp.float32) * scale
        p = jax.nn.softmax(s, axis=-1).astype(v.dtype)
        return jnp.einsum('bhqk,bkhd->bqhd', p, v)

    return _merge_blocks(lax.map(one, _query_blocks(q)))


def _diff_attention(q, k, v, rel_bias, lam):
    seq = q.shape[1]
    scale = DIFF_D ** -0.5
    kpos = jnp.arange(seq, dtype=jnp.int32)
    starts = jnp.arange(seq // Q_BLOCK, dtype=jnp.int32) * Q_BLOCK
    table = rel_bias.astype(jnp.float32)

    def one(args):
        qblk, start = args
        qpos = start + jnp.arange(Q_BLOCK, dtype=jnp.int32)
        bucket = _t5_bucket(kpos[None, :] - qpos[:, None])
        bias = jnp.moveaxis(table[bucket], -1, 0)
        s = jnp.einsum('bqhmd,bkhmd->bmhqk', qblk, k).astype(jnp.float32) * scale + bias
        p = jax.nn.softmax(s, axis=-1)
        a = p[:, 0] - lam * p[:, 1]
        return jnp.einsum('bhqk,bkhd->bqhd', a.astype(v.dtype), v)

    return _merge_blocks(lax.map(one, (_query_blocks(q), starts)))


def setup_inputs(seed: int = 0) -> dict:
    key = jax.random.key(seed)
    ks = jax.random.split(key, 24)
    f32 = jnp.float32

    def w(k, shape, fan_in):
        return jax.random.normal(k, shape, f32) * fan_in ** -0.5

    def gain(k, shape):
        return 1.0 + 0.02 * jax.random.normal(k, shape, f32)

    L = DEPTH
    return {
        "x": jax.random.normal(ks[0], (BATCH, SEQ, D_MODEL), f32),
        "attn_norm_w": gain(ks[1], (L, D_MODEL)),
        "w_in": w(ks[2], (L, D_MODEL, IN_WIDTH), D_MODEL),
        "q_a_norm_w": gain(ks[3], (L, Q_LORA)),
        "w_uq": w(ks[4], (L, Q_LORA, MLA_HEADS * MLA_QK), Q_LORA),
        "kv_a_norm_w": gain(ks[5], (L, KV_LORA)),
        "w_ukv": w(ks[6], (L, KV_LORA, MLA_HEADS * (MLA_NOPE + MLA_V)), KV_LORA),
        "mla_q_norm_w": gain(ks[7], (L, MLA_QK)),
        "mla_k_norm_w": gain(ks[8], (L, MLA_QK)),
        "diff_q_norm_w": gain(ks[9], (L, DIFF_D)),
        "diff_k_norm_w": gain(ks[10], (L, DIFF_D)),
        "lambda_q1": 0.1 * jax.random.normal(ks[11], (L, DIFF_D), f32),
        "lambda_k1": 0.1 * jax.random.normal(ks[12], (L, DIFF_D), f32),
        "lambda_q2": 0.1 * jax.random.normal(ks[13], (L, DIFF_D), f32),
        "lambda_k2": 0.1 * jax.random.normal(ks[14], (L, DIFF_D), f32),
        "diff_out_norm_w": gain(ks[15], (L, DIFF_V)),
        "w_out": w(ks[16], (L, MIX_WIDTH, D_MODEL), MIX_WIDTH),
        "mlp_norm_w": gain(ks[17], (L, D_MODEL)),
        "w_up": w(ks[18], (L, D_MODEL, D_FF), D_MODEL),
        "w_down": w(ks[19], (L, D_FF, D_MODEL), D_FF),
        "rel_bias": 0.5 * jax.random.normal(ks[20], (N_BUCKETS, DIFF_HEADS), f32),
    }


def reference(x, attn_norm_w, w_in, q_a_norm_w, w_uq, kv_a_norm_w, w_ukv,
              mla_q_norm_w, mla_k_norm_w, diff_q_norm_w, diff_k_norm_w,
              lambda_q1, lambda_k1, lambda_q2, lambda_k2, diff_out_norm_w,
              w_out, mlp_norm_w, w_up, w_down, rel_bias):
    b, s, _ = x.shape
    cos, sin = _rope_tables(s, x.dtype)
    for layer in range(DEPTH):
        lam_init = 0.8 - 0.6 * math.exp(-0.3 * layer)

        h = _rmsnorm(x, attn_norm_w[layer])
        proj = h @ w_in[layer]
        c_q, c_kv, k_rope, dq, dk, dv = jnp.split(proj, SPLITS, axis=-1)

        q = (_rmsnorm(c_q, q_a_norm_w[layer]) @ w_uq[layer]).reshape(b, s, MLA_HEADS, MLA_QK)
        q_nope, q_rope = q[..., :MLA_NOPE], q[..., MLA_NOPE:]
        q_rope = q_rope * cos[:, None, :] + _rotate_half(q_rope) * sin[:, None, :]
        kv = (_rmsnorm(c_kv, kv_a_norm_w[layer]) @ w_ukv[layer]).reshape(b, s, MLA_HEADS, MLA_NOPE + MLA_V)
        k_nope, v_mla = kv[..., :MLA_NOPE], kv[..., MLA_NOPE:]
        k_rope = k_rope * cos + _rotate_half(k_rope) * sin
        k_rope = jnp.broadcast_to(k_rope[:, :, None, :], (b, s, MLA_HEADS, MLA_ROPE))
        q_m = _rmsnorm(jnp.concatenate([q_nope, q_rope], axis=-1), mla_q_norm_w[layer])
        k_m = _rmsnorm(jnp.concatenate([k_nope, k_rope], axis=-1), mla_k_norm_w[layer])
        o_mla = _mla_attention(q_m, k_m, v_mla).reshape(b, s, MLA_WIDTH)

        dq = _rmsnorm(dq.reshape(b, s, DIFF_HEADS, 2, DIFF_D), diff_q_norm_w[layer])
        dk = _rmsnorm(dk.reshape(b, s, DIFF_HEADS, 2, DIFF_D), diff_k_norm_w[layer])
        dv = dv.reshape(b, s, DIFF_HEADS, DIFF_V)
        lam = (jnp.exp(jnp.sum(lambda_q1[layer].astype(jnp.float32) * lambda_k1[layer].astype(jnp.float32)))
               - jnp.exp(jnp.sum(lambda_q2[layer].astype(jnp.float32) * lambda_k2[layer].astype(jnp.float32)))
               + lam_init)
        o_d = _diff_attention(dq, dk, dv, rel_bias, lam)
        o_diff = (_rmsnorm(o_d, diff_out_norm_w[layer]) * (1.0 - lam_init)).reshape(b, s, DIFF_WIDTH)

        x = x + jnp.concatenate([o_mla, o_diff], axis=-1) @ w_out[layer]

        h = _rmsnorm(x, mlp_norm_w[layer])
        x = x + jnp.square(jax.nn.relu(h @ w_up[layer])) @ w_down[layer]
    return x
```

```cpp
#include <hip/hip_runtime.h>
#include <hip/hip_bf16.h>
#include <hip/hip_cooperative_groups.h>
#include <cstdio>
#include <cstdint>
namespace cg = cooperative_groups;
#define DI __device__ __forceinline__
#define LAS __attribute__((address_space(3)))
template <int TAG = 0> DI int fresh_tid(int wv) { int l; asm volatile("v_mbcnt_lo_u32_b32 %0, -1, 0\n\tv_mbcnt_hi_u32_b32 %0, -1, %0 ; site %1" : "=v"(l) : "n"(TAG)); return wv * 64 + l; }
namespace pg8 {
#define PG8_LAS __attribute__((address_space(3)))
typedef unsigned short bf16_t;
typedef short bf16x8 __attribute__((ext_vector_type(8)));
typedef float f32x4 __attribute__((ext_vector_type(4)));
typedef unsigned u32x4 __attribute__((ext_vector_type(4)));
constexpr int BM = 256, BK = 64, HALF = 128, HTB = HALF * BK * 2  , STAGE_BYTES = 8 * HTB, NXCD = 8, WGM = 8;

__host__ __device__ __forceinline__ int lds_byte(int r, int c) { const int st = (r >> 4) * 2 + (c >> 5), rr = r & 15, cc = c & 31, ob = rr * 64 + cc * 2; return st * 1024 + (ob ^ (((ob >> 9) & 1) << 5)); }
__host__ __device__ __forceinline__ void stage_rc(int b, int& R, int& C) { const int st = b / 1024, sb = b % 1024, swz = sb ^ (((sb >> 9) & 1) << 5); R = (st >> 1) * 16 + swz / 64; C = (st & 1) * 32 + (swz % 64) / 2; }
__host__ __device__ __forceinline__ int perm32(int rho) { const int n = rho >> 4, i = rho & 15; return 8 * (i >> 2) + 4 * n + (i & 3); }

struct Unit { int pm, pn; };
struct Gemm { const bf16_t* A; const bf16_t* Bt; int M, N, K, lda; };

struct StaticOrder {
    int nM, nN, nwg, G, c;
    __host__ __device__ void init(int M, int N, int G_, int c_) { nM = M / BM; nN = N / BM; nwg = nM * nN; G = G_; c = c_; }
    __host__ __device__ bool next(int i, Unit& u) const {
        const long L = (long)i * G + c; if (L >= nwg) return false;
        int wgid = (int)L; { const int q = nwg / NXCD, r = nwg % NXCD, xcd = wgid % NXCD, off = wgid / NXCD; wgid = (xcd < r ? xcd * (q + 1) : r * (q + 1) + (xcd - r) * q) + off; }
        const int nig = WGM * nN, gid = wgid / nig, fm = gid * WGM, gsz = (nM - fm) < WGM ? (nM - fm) : WGM;
        u.pm = fm + ((wgid % nig) % gsz); u.pn = (wgid % nig) / gsz; return true;
    }
    __device__ __forceinline__ void a_ready(const Unit&) const {}
    __device__ __forceinline__ void done(const Unit&) const {}
};

__device__ __forceinline__ unsigned cvt_pk_bf16(float lo, float hi) { unsigned r; asm volatile("v_cvt_pk_bf16_f32 %0, %1, %2" : "=v"(r) : "v"(lo), "v"(hi)); return r; }
typedef float f32x2 __attribute__((ext_vector_type(2)));
template <class Epi, class Sched, bool ALIGN_EPI = false, bool SP2 = false>
__device__ __forceinline__ void gemm_phase(PG8_LAS unsigned char* lds, const Gemm g, const Sched& S, const Epi& E, int wv) {
    int tid_ = fresh_tid<50>(wv); const int tid = tid_, wid = __builtin_amdgcn_readfirstlane(tid >> 6), lane = tid & 63, wr = wid >> 2, wc = wid & 3, fr = lane & 15, fq = lane >> 4;
    const int K = g.K, nt = K / BK;
    unsigned voffA[2], voffB[2];
#pragma unroll
    for (int i = 0; i < 2; ++i) { int R, C; stage_rc(tid * 16 + i * 8192, R, C); const int Rb = Epi::PERM ? ((R & ~31) + perm32(R & 31)) : R;
        voffA[i] = (unsigned)(R * g.lda + C) * 2u; voffB[i] = (unsigned)(Rb * K + C) * 2u; }
    const size_t kstep = (size_t)(BK * 2);
    const size_t hstepA = (size_t)HALF * g.lda * 2, hstepB = (size_t)HALF * K * 2;
    const size_t tstepA = 2 * hstepA, tstepB = 2 * hstepB;
    const unsigned ldsw = (unsigned)wid * 1024u;
    const int aoff = lds_byte(wr * 64 + fr, fq * 8), boff = lds_byte(wc * 32 + fr, fq * 8);
#define PG8_SA(b, h) (((b) * 2 + (h)) * HTB)
#define PG8_SB(b, h) ((4 + (b) * 2 + (h)) * HTB)
#define PG8_STAGE(bufoff, gbase, voff) do { _Pragma("unroll") for (int _i = 0; _i < 2; ++_i) \
        __builtin_amdgcn_global_load_lds((const unsigned*)((const char*)(gbase) + (voff)[_i]), (PG8_LAS unsigned*)(lds + (bufoff) + ldsw + _i * 8192), 16, 0, 0); } while (0)
#define PG8_LDA(dst, b, h) do { _Pragma("unroll") for (int m = 0; m < 4; ++m) _Pragma("unroll") for (int k = 0; k < 2; ++k) dst[m][k] = *(const PG8_LAS bf16x8*)(lds + PG8_SA(b, h) + aoff + m * 2048 + k * 1024); } while (0)
#define PG8_LDB(dst, b, h) do { _Pragma("unroll") for (int n = 0; n < 2; ++n) _Pragma("unroll") for (int k = 0; k < 2; ++k) dst[n][k] = *(const PG8_LAS bf16x8*)(lds + PG8_SB(b, h) + boff + n * 2048 + k * 1024); } while (0)
#define PG8_MMA(ai, bj, At, Bt) do { __builtin_amdgcn_s_setprio(1); _Pragma("unroll") for (int m = 0; m < 4; ++m) _Pragma("unroll") for (int n = 0; n < 2; ++n) _Pragma("unroll") for (int k = 0; k < 2; ++k) \
        acc[ai][bj][m][n] = __builtin_amdgcn_mfma_f32_16x16x32_bf16(Bt[n][k], At[m][k], acc[ai][bj][m][n], 0, 0, 0); __builtin_amdgcn_s_setprio(0); } while (0)
#define PG8_WAIT_V(n) asm volatile("s_waitcnt vmcnt(" #n ")" ::: "memory")
#define PG8_WAIT_L(n) asm volatile("s_waitcnt lgkmcnt(" #n ")" ::: "memory")
#define PG8_BAR __builtin_amdgcn_s_barrier()
#define PG8_SCHED __builtin_amdgcn_sched_barrier(0)
    Unit cur, nxt; int ui = 0;
    if (!S.next(0, cur)) return;
    f32x4 acc[2][2][4][2];
#pragma unroll
    for (int a = 0; a < 2; ++a)
#pragma unroll
        for (int b = 0; b < 2; ++b)
#pragma unroll
            for (int m = 0; m < 4; ++m)
#pragma unroll
                for (int n = 0; n < 2; ++n) acc[a][b][m][n] = (f32x4){0.f, 0.f, 0.f, 0.f};
    bf16x8 At[4][2], B0[2][2], B1[2][2];
    const char* cA = (const char*)g.A + (size_t)cur.pm * tstepA; const char* cB = (const char*)g.Bt + (size_t)cur.pn * tstepB;
    S.a_ready(cur);
    if constexpr (SP2) {
        PG8_STAGE(PG8_SB(0, 0), cB, voffB); PG8_STAGE(PG8_SB(0, 1), cB + hstepB, voffB); PG8_STAGE(PG8_SA(0, 0), cA, voffA); PG8_STAGE(PG8_SA(0, 1), cA + hstepA, voffA);
        if (wr == 1) PG8_BAR;
        PG8_WAIT_V(2); PG8_BAR;
        PG8_STAGE(PG8_SB(1, 0), cB + kstep, voffB); PG8_STAGE(PG8_SA(1, 0), cA + kstep, voffA); PG8_STAGE(PG8_SB(1, 1), cB + hstepB + kstep, voffB);
        PG8_WAIT_V(6); PG8_BAR;
    } else {
        PG8_STAGE(PG8_SB(0, 0), cB, voffB); PG8_STAGE(PG8_SA(0, 0), cA, voffA); PG8_STAGE(PG8_SB(0, 1), cB + hstepB, voffB); PG8_STAGE(PG8_SA(0, 1), cA + hstepA, voffA);
        if (wr == 1) PG8_BAR;
        PG8_WAIT_V(4); PG8_BAR;
        PG8_STAGE(PG8_SB(1, 0), cB + kstep, voffB); PG8_STAGE(PG8_SA(1, 0), cA + kstep, voffA); PG8_STAGE(PG8_SB(1, 1), cB + hstepB + kstep, voffB);
        PG8_WAIT_V(6); PG8_BAR;
    }
    for (;;) {
        const bool has_next = S.next(ui + 1, nxt);
        const char* nA = has_next ? (const char*)g.A + (size_t)nxt.pm * tstepA : cA; const char* nB = has_next ? (const char*)g.Bt + (size_t)nxt.pn * tstepB : cB;
        for (int t = 0; t < nt; t += 2) {
            const bool last = (t == nt - 2);
            const char* a1 = cA + (size_t)(t + 1) * kstep;
            const char* a2 = last ? nA : cA + (size_t)(t + 2) * kstep; const char* b2 = last ? nB : cB + (size_t)(t + 2) * kstep;
            const char* a3 = a2 + kstep; const char* b3 = b2 + kstep;
            if (last && has_next) S.a_ready(nxt);
            if constexpr (SP2) {
            PG8_LDB(B0, 0, 0); PG8_LDB(B1, 0, 1); PG8_SCHED; PG8_LDA(At, 0, 0); PG8_STAGE(PG8_SA(1, 1), a1 + hstepA, voffA);
            PG8_WAIT_V(8); PG8_WAIT_L(0); PG8_BAR; PG8_MMA(0, 0, At, B0); PG8_MMA(0, 1, At, B1); PG8_BAR; PG8_SCHED;
            PG8_LDA(At, 0, 1); PG8_STAGE(PG8_SB(0, 0), b2, voffB); PG8_STAGE(PG8_SB(0, 1), b2 + hstepB, voffB); PG8_STAGE(PG8_SA(0, 0), a2, voffA);
            PG8_WAIT_V(8); PG8_WAIT_L(0); PG8_BAR; PG8_MMA(1, 0, At, B0); PG8_MMA(1, 1, At, B1); PG8_BAR; PG8_SCHED;
            PG8_LDB(B0, 1, 0); PG8_LDB(B1, 1, 1); PG8_SCHED; PG8_LDA(At, 1, 0); PG8_STAGE(PG8_SA(0, 1), a2 + hstepA, voffA);
            PG8_WAIT_V(8); PG8_WAIT_L(0); PG8_BAR; PG8_MMA(0, 0, At, B0); PG8_MMA(0, 1, At, B1); PG8_BAR; PG8_SCHED;
            PG8_LDA(At, 1, 1); PG8_STAGE(PG8_SB(1, 0), b3, voffB); PG8_STAGE(PG8_SB(1, 1), b3 + hstepB, voffB); PG8_STAGE(PG8_SA(1, 0), a3, voffA);
            PG8_WAIT_V(8); PG8_WAIT_L(0); PG8_BAR; PG8_MMA(1, 0, At, B0); PG8_MMA(1, 1, At, B1); PG8_BAR; PG8_SCHED;
            } else {
            PG8_LDB(B0, 0, 0); PG8_SCHED; PG8_LDA(At, 0, 0); PG8_STAGE(PG8_SA(1, 1), a1 + hstepA, voffA);
            PG8_WAIT_L(8); PG8_BAR; PG8_WAIT_L(0); PG8_MMA(0, 0, At, B0); PG8_BAR; PG8_SCHED;
            PG8_LDB(B1, 0, 1); PG8_STAGE(PG8_SB(0, 0), b2, voffB);
            PG8_BAR; PG8_WAIT_L(0); PG8_MMA(0, 1, At, B1); PG8_BAR;
            PG8_LDA(At, 0, 1); PG8_STAGE(PG8_SA(0, 0), a2, voffA);
            PG8_BAR; PG8_WAIT_L(0); PG8_MMA(1, 0, At, B0); PG8_BAR; PG8_SCHED;
            PG8_STAGE(PG8_SB(0, 1), b2 + hstepB, voffB);
            PG8_WAIT_V(6); PG8_BAR; PG8_MMA(1, 1, At, B1); PG8_BAR;
            PG8_LDB(B0, 1, 0); PG8_SCHED; PG8_LDA(At, 1, 0); PG8_STAGE(PG8_SA(0, 1), a2 + hstepA, voffA);
            PG8_WAIT_L(8); PG8_BAR; PG8_WAIT_L(0); PG8_MMA(0, 0, At, B0); PG8_BAR; PG8_SCHED;
            PG8_LDB(B1, 1, 1); PG8_STAGE(PG8_SB(1, 0), b3, voffB);
            PG8_BAR; PG8_WAIT_L(0); PG8_MMA(0, 1, At, B1); PG8_BAR;
            PG8_LDA(At, 1, 1); PG8_STAGE(PG8_SA(1, 0), a3, voffA);
            PG8_BAR; PG8_WAIT_L(0); PG8_MMA(1, 0, At, B0); PG8_BAR; PG8_SCHED;
            PG8_STAGE(PG8_SB(1, 1), b3 + hstepB, voffB);
            PG8_WAIT_V(6); PG8_BAR; PG8_MMA(1, 1, At, B1); PG8_BAR;
            }
        }
        if constexpr (ALIGN_EPI) { if (wr == 0) PG8_BAR; }
        if constexpr (!Epi::AFTER_DRAIN) { E(acc, cur, wr, wc, fr, fq); S.done(cur); }
        if (!has_next) break;
#pragma unroll
        for (int a = 0; a < 2; ++a)
#pragma unroll
            for (int b = 0; b < 2; ++b)
#pragma unroll
                for (int m = 0; m < 4; ++m)
#pragma unroll
                    for (int n = 0; n < 2; ++n) acc[a][b][m][n] = (f32x4){0.f, 0.f, 0.f, 0.f};
        cur = nxt; cA = nA; cB = nB; ++ui;
        if constexpr (ALIGN_EPI) { if (wr == 1) PG8_BAR; }
    }
    PG8_WAIT_V(0);
    if constexpr (!ALIGN_EPI) { if (wr == 0) PG8_BAR; }
    PG8_BAR;
    if constexpr (Epi::AFTER_DRAIN) { E.fused(acc, cur, wr, wc, fr, fq, lds, wid, lane); S.done(cur); }
#undef PG8_SA
#undef PG8_SB
#undef PG8_STAGE
#undef PG8_LDA
#undef PG8_LDB
#undef PG8_MMA
#undef PG8_WAIT_V
#undef PG8_WAIT_L
#undef PG8_BAR
#undef PG8_SCHED
}
}
using pg8::bf16_t; using pg8::f32x4; using pg8::u32x4; using pg8::Unit; using pg8::cvt_pk_bf16;
typedef unsigned u32x2 __attribute__((ext_vector_type(2)));
constexpr int M_TOK = 65536, SEQ = 4096;
constexpr float EPS = 1e-6f, LOG2E = 1.4426950408889634f;
constexpr size_t MiB = 1ull << 20;
constexpr size_t WS_XB = 0, WS_P = 128 * MiB, WS_Q = 384 * MiB, WS_KM = 480 * MiB, WS_V = 576 * MiB, WS_U = 128 * MiB, WS_AO = 640 * MiB, WS_KR = 768 * MiB,
                 WS_WIN = 784 * MiB, WS_WUQ = 788 * MiB, WS_WUKV = 789 * MiB, WS_WOUT = 790 * MiB, WS_WUP = 792 * MiB, WS_WDN = 800 * MiB,
                 WS_RSTD1 = 808 * MiB, WS_RSTDQ = WS_RSTD1 + 256 * 1024, WS_RSTDKV = WS_RSTDQ + 256 * 1024, WS_SSKR = WS_RSTDKV + 256 * 1024, WS_ROPE = 809 * MiB, WS_SSQ2 = 810 * MiB,
                 WS_MISC = 814 * MiB, WS_SSUM2 = WS_MISC + 64 * 1024, WS_SSQ4 = 815 * MiB, WS_SSKV4 = 816 * MiB, WS_SSKR2 = 817 * MiB, WS_S0 = 832 * MiB, WS_BAR = 960 * MiB, WS_END = 961 * MiB;
struct Params {
    const float *x, *attn_norm_w, *w_in, *q_a_norm_w, *w_uq, *kv_a_norm_w, *w_ukv, *mla_q_norm_w, *mla_k_norm_w, *diff_q_norm_w, *diff_k_norm_w,
                *lambda_q1, *lambda_k1, *lambda_q2, *lambda_k2, *diff_out_norm_w, *w_out, *mlp_norm_w, *w_up, *w_down, *rel_bias;
    float* out; unsigned char* ws;
};
DI float bf2f(unsigned short h) { return __uint_as_float((unsigned)h << 16); }
DI unsigned short f2bf(float x) { unsigned u = __float_as_uint(x); u += 0x7fffu + ((u >> 16) & 1u); return (unsigned short)(u >> 16); }
DI float shx(float v, int mask, int lane) { return __int_as_float(__builtin_amdgcn_ds_bpermute((lane ^ mask) << 2, __float_as_int(v))); }
DI float shl_from(float v, int src) { return __int_as_float(__builtin_amdgcn_ds_bpermute(src << 2, __float_as_int(v))); }
DI float wave_sum(float v, int lane) {
#pragma unroll
    for (int m = 32; m >= 1; m >>= 1) v += shx(v, m, lane);
    return v;
}

struct EpiProj {
    static constexpr bool PERM = true, AFTER_DRAIN = false;
    bf16_t* O; const float* rs; float* ssq4; float* sskv4; float* sskr2; float* KR; const float* cs; const float* sn; const float* gdq; const float* gdk;
    DI void operator()(const f32x4 (&acc)[2][2][4][2], const Unit& u, int wr, int wc, int fr, int fq) const {
        const int row0 = u.pm * 256 + wr * 64 + fr, pn = u.pn, ln = fq * 16 + fr;
        if (pn >= 2 && pn < 6) {
            const float* gp = pn < 4 ? gdq : gdk; const float gsc = pn < 4 ? 0.125f * LOG2E : 1.f;
            f32x4 g[2][2];
#pragma unroll
            for (int bj = 0; bj < 2; ++bj)
#pragma unroll
                for (int n = 0; n < 2; ++n) g[bj][n] = *(const f32x4*)(gp + 32 * bj + 8 * fq + 4 * n) * gsc;
#pragma unroll
            for (int ai = 0; ai < 2; ++ai)
#pragma unroll
                for (int m = 0; m < 4; ++m) { const int row = row0 + ai * 128 + m * 16; const float s = rs[row]; float ss = 0.f;
#pragma unroll
                    for (int bj = 0; bj < 2; ++bj)
#pragma unroll
                        for (int n = 0; n < 2; ++n) { const f32x4 v = acc[ai][bj][m][n]; ss += (v[0] * v[0] + v[1] * v[1]) + (v[2] * v[2] + v[3] * v[3]); }
                    ss += shx(ss, 16, ln); ss += shx(ss, 32, ln);
                    const float r = s * rsqrtf(ss * s * s * (1.f / 64.f) + EPS);
                    bf16_t* rowp = O + (size_t)row * 2048 + pn * 256 + 64 * wc + 8 * fq;
#pragma unroll
                    for (int bj = 0; bj < 2; ++bj) { const f32x4 v0 = acc[ai][bj][m][0] * r * g[bj][0], v1 = acc[ai][bj][m][1] * r * g[bj][1]; u32x4 w;
                        w.x = cvt_pk_bf16(v0[0], v0[1]); w.y = cvt_pk_bf16(v0[2], v0[3]); w.z = cvt_pk_bf16(v1[0], v1[1]); w.w = cvt_pk_bf16(v1[2], v1[3]);
                        *(u32x4*)(rowp + 32 * bj) = w; } }
            return;
        }
        const int col0 = pn * 256 + wc * 32 + 8 * fq;
#pragma unroll
        for (int ai = 0; ai < 2; ++ai)
#pragma unroll
            for (int m = 0; m < 4; ++m) { const int row = row0 + ai * 128 + m * 16; const float s = rs[row]; bf16_t* rowp = O + (size_t)row * 2048 + col0;
                f32x4 v[2][2];
#pragma unroll
                for (int bj = 0; bj < 2; ++bj) { v[bj][0] = acc[ai][bj][m][0] * s; v[bj][1] = acc[ai][bj][m][1] * s; u32x4 w;
                    w.x = cvt_pk_bf16(v[bj][0][0], v[bj][0][1]); w.y = cvt_pk_bf16(v[bj][0][2], v[bj][0][3]); w.z = cvt_pk_bf16(v[bj][1][0], v[bj][1][1]); w.w = cvt_pk_bf16(v[bj][1][2], v[bj][1][3]);
                    *(u32x4*)(rowp + bj * 128) = w; }
                if (pn < 2) {
                    float s0 = 0.f, s1 = 0.f;
#pragma unroll
                    for (int n = 0; n < 2; ++n) { s0 += (v[0][n][0] * v[0][n][0] + v[0][n][1] * v[0][n][1]) + (v[0][n][2] * v[0][n][2] + v[0][n][3] * v[0][n][3]);
                                                  s1 += (v[1][n][0] * v[1][n][0] + v[1][n][1] * v[1][n][1]) + (v[1][n][2] * v[1][n][2] + v[1][n][3] * v[1][n][3]); }
                    if (pn == 0) { float ss = s0 + s1; ss += shx(ss, 16, ln); ss += shx(ss, 32, ln); if (fq == 0) ssq4[(size_t)row * 4 + wc] = ss; }
                    else { s0 += shx(s0, 16, ln); s0 += shx(s0, 32, ln); if (fq == 0) sskv4[(size_t)row * 4 + wc] = s0;
                        if (wc < 2) { s1 += shx(s1, 16, ln); s1 += shx(s1, 32, ln); if (fq == 0) sskr2[(size_t)row * 2 + wc] = s1;
                            const int i0 = 16 * wc + 4 * fq, pos = row & (SEQ - 1); const f32x4 c = *(const f32x4*)(cs + pos * 32 + i0), sv = *(const f32x4*)(sn + pos * 32 + i0);
                            *(f32x4*)(KR + (size_t)row * 64 + i0) = v[1][0] * c - v[1][1] * sv; *(f32x4*)(KR + (size_t)row * 64 + 32 + i0) = v[1][1] * c + v[1][0] * sv; } } } }
    }
};
struct EpiQ {
    static constexpr bool PERM = true, AFTER_DRAIN = false;
    bf16_t* Q; const float* ssq4; const float* cs; const float* sn;
    DI void operator()(const f32x4 (&acc)[2][2][4][2], const Unit& u, int wr, int wc, int fr, int fq) const {
        const int row0 = u.pm * 256 + wr * 64 + fr;
#pragma unroll
        for (int ai = 0; ai < 2; ++ai)
#pragma unroll
            for (int m = 0; m < 4; ++m) { const int row = row0 + ai * 128 + m * 16; const f32x4 q4 = *(const f32x4*)(ssq4 + (size_t)row * 4);
                const float s = rsqrtf(((q4[0] + q4[1]) + (q4[2] + q4[3])) * (1.f / 256.f) + EPS); bf16_t* rowp = Q + (size_t)row * 768;
#pragma unroll
                for (int bj = 0; bj < 2; ++bj) { const int c0 = u.pn * 256 + bj * 128 + wc * 32, h = c0 / 192, d0 = c0 - h * 192;
                    if (d0 < 128) { const f32x4 v0 = acc[ai][bj][m][0] * s, v1 = acc[ai][bj][m][1] * s; u32x4 w;
                        w.x = cvt_pk_bf16(v0[0], v0[1]); w.y = cvt_pk_bf16(v0[2], v0[3]); w.z = cvt_pk_bf16(v1[0], v1[1]); w.w = cvt_pk_bf16(v1[2], v1[3]);
                        *(u32x4*)(rowp + c0 + 8 * fq) = w; }
                    else { const int i0 = 16 * (wc & 1) + 4 * fq, pos = row & (SEQ - 1);
                        const f32x4 c = *(const f32x4*)(cs + pos * 32 + i0), sv = *(const f32x4*)(sn + pos * 32 + i0);
                        const f32x4 x1 = acc[ai][bj][m][0] * s, x2 = acc[ai][bj][m][1] * s; const f32x4 o1 = x1 * c - x2 * sv, o2 = x2 * c + x1 * sv; u32x2 a, b;
                        a.x = cvt_pk_bf16(o1[0], o1[1]); a.y = cvt_pk_bf16(o1[2], o1[3]); b.x = cvt_pk_bf16(o2[0], o2[1]); b.y = cvt_pk_bf16(o2[2], o2[3]);
                        *(u32x2*)(rowp + h * 192 + 128 + i0) = a; *(u32x2*)(rowp + h * 192 + 160 + i0) = b; } } }
    }
};
struct EpiKV {
    static constexpr bool PERM = true, AFTER_DRAIN = false;
    bf16_t* KM; bf16_t* V; const float* sskv4; const float* KR; const float* sskr2; const float* gk; LAS float* part;
    DI void operator()(const f32x4 (&acc)[2][2][4][2], const Unit& u, int wr, int wc, int fr, int fq) const {
        typedef float f32x2_ __attribute__((ext_vector_type(2)));
        const int row0 = u.pm * 256 + wr * 64 + fr, h = u.pn, cw = wc * 32 + 8 * fq, ln = fq * 16 + fr;
        float rs[2][4];
#pragma unroll
        for (int ai = 0; ai < 2; ++ai)
#pragma unroll
            for (int m = 0; m < 4; ++m) { const f32x4 q4 = *(const f32x4*)(sskv4 + (size_t)(row0 + ai * 128 + m * 16) * 4); rs[ai][m] = rsqrtf(((q4[0] + q4[1]) + (q4[2] + q4[3])) * (1.f / 128.f) + EPS); }
#pragma unroll
        for (int ai = 0; ai < 2; ++ai)
#pragma unroll
            for (int m = 0; m < 4; ++m) { const int row = row0 + ai * 128 + m * 16; const float s = rs[ai][m];
                const f32x4 w0 = acc[ai][1][m][0] * s, w1 = acc[ai][1][m][1] * s; u32x4 w;
                w.x = cvt_pk_bf16(w0[0], w0[1]); w.y = cvt_pk_bf16(w0[2], w0[3]); w.z = cvt_pk_bf16(w1[0], w1[1]); w.w = cvt_pk_bf16(w1[2], w1[3]);
                *(u32x4*)(V + (size_t)row * 512 + h * 128 + cw) = w;
                const f32x4 v0 = acc[ai][0][m][0] * s, v1 = acc[ai][0][m][1] * s;
                float ss = ((v0[0] * v0[0] + v0[1] * v0[1]) + (v0[2] * v0[2] + v0[3] * v0[3])) + ((v1[0] * v1[0] + v1[1] * v1[1]) + (v1[2] * v1[2] + v1[3] * v1[3]));
                ss += shx(ss, 16, ln); ss += shx(ss, 32, ln);
                if (fq == 0) part[(ai * 128 + wr * 64 + m * 16 + fr) * 4 + wc] = ss; }
        const f32x4 g0 = *(const f32x4*)(gk + cw), g1 = *(const f32x4*)(gk + cw + 4), gr = *(const f32x4*)(gk + 128 + wc * 16 + fq * 4);
        asm volatile("s_waitcnt lgkmcnt(0)" ::: "memory"); __builtin_amdgcn_s_barrier(); asm volatile("" ::: "memory");
#pragma unroll
        for (int ai = 0; ai < 2; ++ai)
#pragma unroll
            for (int m = 0; m < 4; ++m) { const int row = row0 + ai * 128 + m * 16; const f32x4 pp = *(const LAS f32x4*)(part + (ai * 128 + wr * 64 + m * 16 + fr) * 4);
                const f32x2_ kr2 = *(const f32x2_*)(sskr2 + (size_t)row * 2);
                const float rstd = rsqrtf((((pp[0] + pp[1]) + (pp[2] + pp[3])) + (kr2[0] + kr2[1])) * (1.f / 192.f) + EPS), s = rs[ai][m] * rstd;
                const f32x4 v0 = acc[ai][0][m][0] * s * g0, v1 = acc[ai][0][m][1] * s * g1; u32x4 w;
                w.x = cvt_pk_bf16(v0[0], v0[1]); w.y = cvt_pk_bf16(v0[2], v0[3]); w.z = cvt_pk_bf16(v1[0], v1[1]); w.w = cvt_pk_bf16(v1[2], v1[3]);
                bf16_t* kp = KM + (size_t)row * 768 + h * 192;
                *(u32x4*)(kp + cw) = w;
                const f32x4 kr = *(const f32x4*)(KR + (size_t)row * 64 + wc * 16 + fq * 4) * rstd * gr; u32x2 r2; r2.x = cvt_pk_bf16(kr[0], kr[1]); r2.y = cvt_pk_bf16(kr[2], kr[3]);
                *(u32x2*)(kp + 128 + wc * 16 + fq * 4) = r2; }
    }
};
struct EpiOut {
    static constexpr bool PERM = true, AFTER_DRAIN = false;
    bf16_t* x1b; float* ssum2;
    DI void operator()(const f32x4 (&acc)[2][2][4][2], const Unit& u, int wr, int wc, int fr, int fq) const {
        const int row0 = u.pm * 256 + wr * 64 + fr, col0 = u.pn * 256 + wc * 32 + 8 * fq;
#pragma unroll
        for (int ai = 0; ai < 2; ++ai)
#pragma unroll
            for (int m = 0; m < 4; ++m) { const int row = row0 + ai * 128 + m * 16; const size_t off = (size_t)row * 1024 + col0; float ss = 0.f;
#pragma unroll
                for (int bj = 0; bj < 2; ++bj) { const size_t o = off + bj * 128; const u32x4 r_ = *(const u32x4*)(x1b + o); f32x4 v0, v1;
                    v0[0] = __uint_as_float(r_.x << 16); v0[1] = __uint_as_float(r_.x & 0xffff0000u); v0[2] = __uint_as_float(r_.y << 16); v0[3] = __uint_as_float(r_.y & 0xffff0000u);
                    v1[0] = __uint_as_float(r_.z << 16); v1[1] = __uint_as_float(r_.z & 0xffff0000u); v1[2] = __uint_as_float(r_.w << 16); v1[3] = __uint_as_float(r_.w & 0xffff0000u);
                    v0 = v0 + acc[ai][bj][m][0]; v1 = v1 + acc[ai][bj][m][1];
                    ss += ((v0[0] * v0[0] + v0[1] * v0[1]) + (v0[2] * v0[2] + v0[3] * v0[3])) + ((v1[0] * v1[0] + v1[1] * v1[1]) + (v1[2] * v1[2] + v1[3] * v1[3]));
                    u32x4 w; w.x = cvt_pk_bf16(v0[0], v0[1]); w.y = cvt_pk_bf16(v0[2], v0[3]); w.z = cvt_pk_bf16(v1[0], v1[1]); w.w = cvt_pk_bf16(v1[2], v1[3]); *(u32x4*)(x1b + o) = w; }
                { const int ln_ = fq * 16 + fr; ss += shx(ss, 16, ln_); ss += shx(ss, 32, ln_); }
                if (fq == 0) unsafeAtomicAdd(ssum2 + row, ss); }
    }
};
struct EpiUp {
    static constexpr bool PERM = true, AFTER_DRAIN = false;
    bf16_t* U; const float* ssum2;
    DI void operator()(const f32x4 (&acc)[2][2][4][2], const Unit& u, int wr, int wc, int fr, int fq) const {
        const int row0 = u.pm * 256 + wr * 64 + fr, col0 = u.pn * 256 + wc * 32 + 8 * fq;
#pragma unroll
        for (int ai = 0; ai < 2; ++ai)
#pragma unroll
            for (int m = 0; m < 4; ++m) { const int row = row0 + ai * 128 + m * 16; const float s = rsqrtf(ssum2[row] * (1.f / 1024.f) + EPS);
                bf16_t* rowp = U + (size_t)row * 4096 + col0;
#pragma unroll
                for (int bj = 0; bj < 2; ++bj) { f32x4 v0 = acc[ai][bj][m][0] * s, v1 = acc[ai][bj][m][1] * s;
#pragma unroll
                    for (int j = 0; j < 4; ++j) { const float a = fmaxf(v0[j], 0.f), b = fmaxf(v1[j], 0.f); v0[j] = a * a; v1[j] = b * b; }
                    u32x4 w; w.x = cvt_pk_bf16(v0[0], v0[1]); w.y = cvt_pk_bf16(v0[2], v0[3]); w.z = cvt_pk_bf16(v1[0], v1[1]); w.w = cvt_pk_bf16(v1[2], v1[3]);
                    __builtin_nontemporal_store(w, (u32x4*)(rowp + bj * 128)); } }
    }
};
struct EpiDown {
    static constexpr bool PERM = true, AFTER_DRAIN = false;
    float* out; const bf16_t* x1b;
    DI void operator()(const f32x4 (&acc)[2][2][4][2], const Unit& u, int wr, int wc, int fr, int fq) const {
        const int row0 = u.pm * 256 + wr * 64 + fr, col0 = u.pn * 256 + wc * 32 + 8 * fq;
#pragma unroll
        for (int ai = 0; ai < 2; ++ai)
#pragma unroll
            for (int m = 0; m < 4; ++m) { const size_t off = (size_t)(row0 + ai * 128 + m * 16) * 1024 + col0;
#pragma unroll
                for (int bj = 0; bj < 2; ++bj) { const size_t o = off + bj * 128; const u32x4 r = *(const u32x4*)(x1b + o); f32x4 v0, v1;
                    v0[0] = __uint_as_float(r.x << 16); v0[1] = __uint_as_float(r.x & 0xffff0000u); v0[2] = __uint_as_float(r.y << 16); v0[3] = __uint_as_float(r.y & 0xffff0000u);
                    v1[0] = __uint_as_float(r.z << 16); v1[1] = __uint_as_float(r.z & 0xffff0000u); v1[2] = __uint_as_float(r.w << 16); v1[3] = __uint_as_float(r.w & 0xffff0000u);
                    __builtin_nontemporal_store(v0 + acc[ai][bj][m][0], (f32x4*)(out + o)); __builtin_nontemporal_store(v1 + acc[ai][bj][m][1], (f32x4*)(out + o + 4)); } }
    }
};
namespace att {
typedef short bf16x8 __attribute__((ext_vector_type(8)));
typedef short s16x4 __attribute__((ext_vector_type(4)));
typedef float f32x16 __attribute__((ext_vector_type(16)));
constexpr int SHM_V = 16384, KBUF_MAX = 64 * 192 * 2, V_OFF = 4 * KBUF_MAX, WS_OFF = V_OFF + 3 * SHM_V, BT_OFF = WS_OFF + 8 * 64 * 4, ATT_LDS = BT_OFF + 1800;
#define SBAR() __builtin_amdgcn_sched_barrier(0)
DI int crow(int r, int hi) { return (r & 3) + 8 * (r >> 2) + 4 * hi; }
DI unsigned cvtpk(float lo, float hi) { unsigned r; asm volatile("v_cvt_pk_bf16_f32 %0, %1, %2" : "=v"(r) : "v"(lo), "v"(hi)); return r; }
template <int DQK> DI int kswz(int row, int colB) { return row * (DQK * 2) + (colB ^ (((row >> 1) & 7) << 4)); }
DI float swap_sum(float v) { auto rr = __builtin_amdgcn_permlane32_swap(__float_as_uint(v), __float_as_uint(v), false, false); return __uint_as_float(rr[0]) + __uint_as_float(rr[1]); }

DI void expsum(f32x16& p, float& l_reg, bf16x8& pa0, bf16x8& pa1) {
#pragma unroll
    for (int r = 0; r < 16; ++r) p[r] = __builtin_amdgcn_exp2f(p[r]);
    float ps = 0.f;
#pragma unroll
    for (int r = 0; r < 16; ++r) ps += p[r];
    l_reg += ps; asm volatile("" : "+v"(l_reg));
#define ATT_PK4(P, BASE, OUT) do { unsigned a0 = cvtpk(P[BASE + 0], P[BASE + 1]), a1 = cvtpk(P[BASE + 2], P[BASE + 3]);   \
    unsigned b0 = cvtpk(P[BASE + 4], P[BASE + 5]), b1 = cvtpk(P[BASE + 6], P[BASE + 7]);                              \
    auto r0 = __builtin_amdgcn_permlane32_swap(a0, b0, false, false); auto r1 = __builtin_amdgcn_permlane32_swap(a1, b1, false, false); \
    u32x4 w = {r0[0], r1[0], r0[1], r1[1]}; OUT = __builtin_bit_cast(bf16x8, w); } while (0)
    ATT_PK4(p, 0, pa0); ATT_PK4(p, 8, pa1);
#undef ATT_PK4
}
DI int v_rd_base(int lane) { return ((lane & 3) << 3) | (((lane >> 2) & 3) << 6) | (((lane >> 4) & 1) << 5) | (((lane >> 5) & 1) << 8); }
constexpr int v_rd_off(int d0, int ks, int half) { return d0 * 512 + ks * 4096 + half * 2048; }
template <int OFF> DI s16x4 tr_read(int vb) { s16x4 r; asm volatile("ds_read_b64_tr_b16 %0, %1 offset:%2" : "=&v"(r) : "v"(vb), "i"(OFF) : "memory"); return r; }
template <int H> DI void v_reads(s16x4* vf, int vb) {
    vf[0] = tr_read<v_rd_off(0, 2 * H, 0)>(vb); vf[1] = tr_read<v_rd_off(0, 2 * H, 1)>(vb); vf[2] = tr_read<v_rd_off(0, 2 * H + 1, 0)>(vb); vf[3] = tr_read<v_rd_off(0, 2 * H + 1, 1)>(vb);
    vf[4] = tr_read<v_rd_off(1, 2 * H, 0)>(vb); vf[5] = tr_read<v_rd_off(1, 2 * H, 1)>(vb); vf[6] = tr_read<v_rd_off(1, 2 * H + 1, 0)>(vb); vf[7] = tr_read<v_rd_off(1, 2 * H + 1, 1)>(vb);
    vf[8] = tr_read<v_rd_off(2, 2 * H, 0)>(vb); vf[9] = tr_read<v_rd_off(2, 2 * H, 1)>(vb); vf[10] = tr_read<v_rd_off(2, 2 * H + 1, 0)>(vb); vf[11] = tr_read<v_rd_off(2, 2 * H + 1, 1)>(vb);
    vf[12] = tr_read<v_rd_off(3, 2 * H, 0)>(vb); vf[13] = tr_read<v_rd_off(3, 2 * H, 1)>(vb); vf[14] = tr_read<v_rd_off(3, 2 * H + 1, 0)>(vb); vf[15] = tr_read<v_rd_off(3, 2 * H + 1, 1)>(vb);
}
DI void pv_mma(f32x16* o, const s16x4* vf, bf16x8 pa0, bf16x8 pa1) {
#define ATT_PK(L, H_) (bf16x8){L[0], L[1], L[2], L[3], H_[0], H_[1], H_[2], H_[3]}
#pragma unroll
    for (int d0 = 0; d0 < 4; ++d0) {
        o[d0] = __builtin_amdgcn_mfma_f32_32x32x16_bf16(pa0, ATT_PK(vf[4 * d0], vf[4 * d0 + 1]), o[d0], 0, 0, 0);
        o[d0] = __builtin_amdgcn_mfma_f32_32x32x16_bf16(pa1, ATT_PK(vf[4 * d0 + 2], vf[4 * d0 + 3]), o[d0], 0, 0, 0); }
#undef ATT_PK
}
template <int DQK, int D0A, int D0B> DI void k_reads(bf16x8* kf, const LAS unsigned char* Ks, int half, int r32, int hi) {
#pragma unroll
    for (int d0 = D0A; d0 < D0B; ++d0) kf[d0 - D0A] = *(const LAS bf16x8*)(Ks + half * (32 * DQK * 2) + kswz<DQK>(r32, (d0 * 16 + hi * 8) * 2));
}
template <int D0A, int D0B> DI void qk_mma(f32x16& p, const bf16x8* kf, const bf16x8* qr) {
#pragma unroll
    for (int d0 = D0A; d0 < D0B; ++d0) {
        if (d0 == 0) { f32x16 z; _Pragma("unroll") for (int r = 0; r < 16; ++r) z[r] = 0.f; p = __builtin_amdgcn_mfma_f32_32x32x16_bf16(kf[0], qr[0], z, 0, 0, 0); }
        else p = __builtin_amdgcn_mfma_f32_32x32x16_bf16(kf[d0 - D0A], qr[d0], p, 0, 0, 0); }
}

template <int DQK, int MODE, int LDQ, int LDK, int LDV>
DI void attn_body(const bf16_t* __restrict__ Qb, const bf16_t* __restrict__ Kh, const bf16_t* __restrict__ Vh, int q0, float C, const float* __restrict__ gq,
                  float* S0, bf16_t* AOb, float lam, const float* __restrict__ gout, LAS unsigned char* lds, int wv) {
    constexpr int KBUF = 64 * DQK * 2, CPR = DQK / 8, NKP = KBUF / 8192, ND0 = DQK / 16, NT = SEQ / 64;
    int tid_ = fresh_tid<100 + MODE>(wv); const int tid = tid_, wid = __builtin_amdgcn_readfirstlane(tid >> 6), lane = tid & 63, r32 = lane & 31, hi = lane >> 5;
    LAS float* ws = (LAS float*)(lds + WS_OFF) + wid * 64; LAS float* li_l = ws;
    const LAS float* bt = (const LAS float*)(lds + BT_OFF);
    float l_reg = 0.f; f32x16 o[4];
#pragma unroll
    for (int d = 0; d < 4; ++d)
#pragma unroll
        for (int r = 0; r < 16; ++r) o[d][r] = 0.f;
    int kgo[NKP], vgo[2];
#pragma unroll
    for (int i = 0; i < NKP; ++i) { const int L = (wid + 8 * i) * 64 + lane, row = L / CPR, slot = L % CPR, cc = (slot & ~7) | ((slot & 7) ^ ((row >> 1) & 7)); kgo[i] = row * LDK + cc * 8; }
#pragma unroll
    for (int i = 0; i < 2; ++i) { const int L = (2 * wid + i) * 64 + lane, st = L >> 5, w5 = L & 31, kk = (st >> 2) * 8 + (w5 >> 2), c = (st & 3) * 32 + (w5 & 3) * 8;
        const int k = (kk & ~0xC) | ((kk & 4) << 1) | ((kk & 8) >> 1); vgo[i] = k * LDV + c; }
#define ATT_DMA_K(t) do { const bf16_t* kg_ = Kh + (size_t)(t) * 64 * LDK; LAS unsigned char* sb_ = lds + ((t) & 3) * KBUF; \
    _Pragma("unroll") for (int i_ = 0; i_ < NKP; ++i_) __builtin_amdgcn_global_load_lds((const unsigned*)(kg_ + kgo[i_]), (LAS unsigned*)(sb_ + (wid + 8 * i_) * 1024), 16, 0, 0); } while (0)
#define ATT_DMA_V(t, vs) do { const bf16_t* vg_ = Vh + (size_t)(t) * 64 * LDV; LAS unsigned char* sb_ = lds + V_OFF + (vs) * SHM_V; \
    _Pragma("unroll") for (int i_ = 0; i_ < 2; ++i_) __builtin_amdgcn_global_load_lds((const unsigned*)(vg_ + vgo[i_]), (LAS unsigned*)(sb_ + (2 * wid + i_) * 1024), 16, 0, 0); } while (0)
    ATT_DMA_K(0); ATT_DMA_K(1); ATT_DMA_V(0, 0); ATT_DMA_K(2); ATT_DMA_V(1, 1);
    bf16x8 qr[ND0];
    { const bf16_t* Qw = Qb + (size_t)(wid * 32 + r32) * LDQ + hi * 8;
#pragma unroll
      for (int d0 = 0; d0 < ND0; ++d0) qr[d0] = *(const bf16x8*)(Qw + d0 * 16);
      if constexpr (MODE == 0) {
          float ss = 0.f;
#pragma unroll
          for (int d0 = 0; d0 < ND0; ++d0)
#pragma unroll
              for (int j = 0; j < 8; ++j) { const float f = bf2f((unsigned short)qr[d0][j]); ss += f * f; }
          ss = swap_sum(ss);
          const float rstd = rsqrtf(ss * (1.f / DQK) + EPS) * C;
#pragma unroll
          for (int d0 = 0; d0 < ND0; ++d0) { const float* g = gq + d0 * 16 + hi * 8;
              { float f[8]; _Pragma("unroll") for (int j = 0; j < 8; ++j) f[j] = bf2f((unsigned short)qr[d0][j]) * rstd * g[j];
                u32x4 w = {cvtpk(f[0], f[1]), cvtpk(f[2], f[3]), cvtpk(f[4], f[5]), cvtpk(f[6], f[7])}; qr[d0] = __builtin_bit_cast(bf16x8, w); asm volatile("" ::: "memory"); } }
      } }
    const int qlo = q0 + wid * 32, qpos = qlo + r32;
    const int tL = MODE == 0 ? 0 : (qlo >= 191 ? (qlo - 127) >> 6 : 0), tR = MODE == 0 ? NT : min(NT, (qlo + 222) >> 6);
    float fL = 1.f, fR = 1.f; if constexpr (MODE != 0) { fL = __builtin_amdgcn_exp2f(bt[0]); fR = __builtin_amdgcn_exp2f(-bt[448]); }
#define ATT_SEG(t) do { if constexpr (MODE != 0) { if (((t) == tL && tL > 0) || (t) == tR) { const float f_ = (t) == tR ? fR : fL; l_reg *= f_; \
    _Pragma("unroll") for (int d = 0; d < 4; ++d) _Pragma("unroll") for (int r = 0; r < 16; ++r) o[d][r] *= f_; } } } while (0)
#define ATT_BIAS(P, t, half) do { if constexpr (MODE != 0) { if ((t) >= tL && (t) < tR) { const LAS float* bp_ = bt + ((t) * 64 + (half) * 32 - qpos + 224 + 4 * hi);     \
    _Pragma("unroll") for (int r = 0; r < 16; ++r) P[r] += bp_[(r & 3) + 8 * (r >> 2)]; } } } while (0)
    const int vbase = (int)(unsigned)(size_t)lds + V_OFF + v_rd_base(lane);
#define ATT_TOP(N) do { asm volatile("s_waitcnt vmcnt(%0)" :: "n"(N) : "memory"); __builtin_amdgcn_s_barrier(); asm volatile("" ::: "memory"); } while (0)
#define ATT_LGKM0() do { SBAR(); asm volatile("s_waitcnt lgkmcnt(0)" ::: "memory"); SBAR(); } while (0)
    constexpr int NDA = ND0 > 6 ? 6 : ND0;
#define ATT_STEP(PC, PN, H, SV, DO_NEXT, HN, TN) do { bf16x8 kf[NDA]; s16x4 vf[16]; const LAS unsigned char* ks_ = lds + ((TN) & 3) * KBUF; \
        if (DO_NEXT) k_reads<DQK, 0, NDA>(kf, ks_, HN, r32, hi); \
        v_reads<H>(vf, vbase + (SV) * SHM_V); SBAR(); \
        expsum(PC, l_reg, pa0, pa1); SBAR(); ATT_LGKM0(); \
        if constexpr (ND0 > NDA) { bf16x8 kg[ND0 - NDA]; if (DO_NEXT) k_reads<DQK, NDA, ND0>(kg, ks_, HN, r32, hi); SBAR(); \
            pv_mma(o, vf, pa0, pa1); if (DO_NEXT) { qk_mma<0, NDA>(PN, kf, qr); ATT_LGKM0(); qk_mma<NDA, ND0>(PN, kg, qr); } } \
        else { pv_mma(o, vf, pa0, pa1); if (DO_NEXT) qk_mma<0, NDA>(PN, kf, qr); } \
        if (DO_NEXT) ATT_BIAS(PN, TN, HN); SBAR(); } while (0)
    f32x16 pA, pB; bf16x8 pa0, pa1;
    int v0 = 0, v1 = 1, v2 = 2;
    ATT_TOP(NKP + 2);
    { bf16x8 kf[NDA]; k_reads<DQK, 0, NDA>(kf, lds, 0, r32, hi); ATT_LGKM0(); qk_mma<0, NDA>(pA, kf, qr);
      if constexpr (ND0 > NDA) { bf16x8 kg[ND0 - NDA]; k_reads<DQK, NDA, ND0>(kg, lds, 0, r32, hi); ATT_LGKM0(); qk_mma<NDA, ND0>(pA, kg, qr); }
      ATT_BIAS(pA, 0, 0); }
    if (wid >= 4) __builtin_amdgcn_s_setprio(1);
    for (int j = 0; j < NT; ++j) {
        if (j + 2 < NT) ATT_TOP(NKP + 2); else ATT_TOP(0);
        if (j + 3 < NT) ATT_DMA_K(j + 3);
        if (j + 2 < NT) ATT_DMA_V(j + 2, v2);
        ATT_SEG(j); SBAR();
        ATT_STEP(pA, pB, 0, v0, true, 1, j);
        ATT_STEP(pB, pA, 1, v0, (j + 1 < NT), 0, j + 1);
        { const int t_ = v0; v0 = v1; v1 = v2; v2 = t_; }
    }
    __builtin_amdgcn_s_setprio(0);
#undef ATT_STEP
#undef ATT_LGKM0
    l_reg = swap_sum(l_reg);
    { const int lane2 = fresh_tid<110 + MODE>(wv) & 63, r32 = lane2 & 31, hi = lane2 >> 5;
    if (hi == 0) li_l[r32] = l_reg;
    asm volatile("s_waitcnt lgkmcnt(0)" ::: "memory");
    float s0v[MODE == 2 ? 16 : 1][4];
    if constexpr (MODE == 2) {
#pragma unroll
        for (int r = 0; r < 16; ++r)
#pragma unroll
            for (int d0 = 0; d0 < 4; ++d0) s0v[r][d0] = S0[(size_t)(wid * 32 + crow(r, hi)) * 512 + d0 * 32 + r32];
    }
#pragma unroll
    for (int r = 0; r < 16; ++r) { const int orow = wid * 32 + crow(r, hi); const float rl = __builtin_amdgcn_rcpf(li_l[crow(r, hi)]);
        if constexpr (MODE == 0) {
#pragma unroll
            for (int d0 = 0; d0 < 4; ++d0) AOb[(size_t)orow * 1024 + d0 * 32 + r32] = f2bf(o[d0][r] * rl);
        } else if constexpr (MODE == 1) {
#pragma unroll
            for (int d0 = 0; d0 < 4; ++d0) S0[(size_t)orow * 512 + d0 * 32 + r32] = o[d0][r] * rl;
        } else {
            float v[4]; float ss = 0.f;
#pragma unroll
            for (int d0 = 0; d0 < 4; ++d0) { v[d0] = s0v[r][d0] - lam * (o[d0][r] * rl); ss += v[d0] * v[d0]; }
#pragma unroll
            for (int mk = 1; mk <= 16; mk <<= 1) ss += shx(ss, mk, lane2);
            const float rs = rsqrtf(ss * (1.f / 128.f) + EPS) * 0.8f;
#pragma unroll
            for (int d0 = 0; d0 < 4; ++d0) AOb[(size_t)orow * 1024 + d0 * 32 + r32] = f2bf(v[d0] * rs * gout[d0 * 32 + r32]);
        } }
    }
#undef ATT_DMA_K
#undef ATT_DMA_V
#undef ATT_SEG
#undef ATT_BIAS
#undef ATT_TOP
}
}
struct MapIn  { DI int operator()(int n) const {
                    if (n < 384) return n;
                    if (n < 512) { const int u = n - 384; if (u >= 64) return -1; const int wc = u >> 5, fq = (u >> 3) & 3, nn = (u >> 2) & 1, j = u & 3; return 384 + nn * 32 + 16 * wc + 4 * fq + j; }
                    if (n < 1536) { const int t = n & 255, tb = n - t, bj = t >> 7, wc = (t >> 5) & 3, u = t & 31; return tb + 64 * wc + 32 * bj + u - 64; }
                    return n - 64; } };
struct MapUq  { DI int operator()(int n) const { const int h = n / 192, d = n - h * 192; if (d < 128) return n;
                    const int u = d - 128, w = u >> 5, fq = (u >> 3) & 3, nn = (u >> 2) & 1, j = u & 3; return h * 192 + 128 + nn * 32 + 16 * w + 4 * fq + j; } };
struct MapId  { DI int operator()(int n) const { return n; } };
template <class ColMap>
DI void transpose_w(LAS float* tile, const float* __restrict__ w, int Ksrc, int Nsrc, const float* __restrict__ gain, bf16_t* __restrict__ out, int Nout, int Kout, ColMap cm, int gw, int ngw, int lane) {
    const int tilesK = Kout / 64, ntile = tilesK * (Nout / 64);
    for (int t = gw; t < ntile; t += ngw) { const int k0 = (t % tilesK) * 64, n0 = (t / tilesK) * 64; const int scol = cm(n0 + lane);
#pragma unroll
        for (int c = 0; c < 4; ++c) { float v[16];
#pragma unroll
            for (int i = 0; i < 16; ++i) { const int k = k0 + c * 16 + i; v[i] = (scol >= 0 && k < Ksrc) ? w[(size_t)k * Nsrc + scol] * (gain ? gain[k] : 1.f) : 0.f; }
#pragma unroll
            for (int i = 0; i < 16; ++i) tile[(c * 16 + i) * 65 + lane] = v[i]; }
        asm volatile("s_waitcnt lgkmcnt(0)" ::: "memory");
#pragma unroll 8
        for (int nl = 0; nl < 64; ++nl) out[(size_t)(n0 + nl) * Kout + k0 + lane] = f2bf(tile[lane * 65 + nl]);
        asm volatile("s_waitcnt lgkmcnt(0)" ::: "memory"); }
}
DI void phase0(const Params& p, LAS unsigned char* lds, int wv) {
    int tid_ = fresh_tid<1>(wv); const int tid = tid_, bid = blockIdx.x, nb = gridDim.x, wave = tid >> 6, lane = tid & 63;
    unsigned char* ws = p.ws; LAS float* tile = (LAS float*)lds + wave * (64 * 65);
    const int ngw = nb * 8, gw = bid * 8 + wave;
    transpose_w(tile, p.w_up, 1024, 4096, p.mlp_norm_w, (bf16_t*)(ws + WS_WUP), 4096, 1024, MapId(), gw, ngw, lane);
    transpose_w(tile, p.w_down, 4096, 1024, nullptr, (bf16_t*)(ws + WS_WDN), 1024, 4096, MapId(), (gw + ngw / 2) % ngw, ngw, lane);
    transpose_w(tile, p.w_in, 1024, 1984, p.attn_norm_w, (bf16_t*)(ws + WS_WIN), 2048, 1024, MapIn(), (gw + ngw / 4) % ngw, ngw, lane);
    transpose_w(tile, p.w_out, 1024, 1024, nullptr, (bf16_t*)(ws + WS_WOUT), 1024, 1024, MapId(), (gw + 3 * ngw / 4) % ngw, ngw, lane);
    transpose_w(tile, p.w_uq, 256, 768, p.q_a_norm_w, (bf16_t*)(ws + WS_WUQ), 768, 256, MapUq(), (gw + 7 * ngw / 8) % ngw, ngw, lane);
    transpose_w(tile, p.w_ukv, 128, 1024, p.kv_a_norm_w, (bf16_t*)(ws + WS_WUKV), 1024, 128, MapId(), (gw + 15 * ngw / 16) % ngw, ngw, lane);
    bf16_t* xb = (bf16_t*)(ws + WS_XB); float* rstd1 = (float*)(ws + WS_RSTD1);
    for (int row0 = (bid * 8 + wave) * 4; row0 < M_TOK; row0 += nb * 32) { f32x4 v[4][4]; float ss[4] = {0.f, 0.f, 0.f, 0.f};
#pragma unroll
        for (int q = 0; q < 4; ++q) { const f32x4* xr = (const f32x4*)(p.x + (size_t)(row0 + q) * 1024);
#pragma unroll
            for (int i = 0; i < 4; ++i) v[q][i] = __builtin_nontemporal_load(xr + lane + 64 * i); }
#pragma unroll
        for (int q = 0; q < 4; ++q) {
#pragma unroll
            for (int i = 0; i < 4; ++i) ss[q] += (v[q][i][0] * v[q][i][0] + v[q][i][1] * v[q][i][1]) + (v[q][i][2] * v[q][i][2] + v[q][i][3] * v[q][i][3]);
#pragma unroll
            for (int i = 0; i < 4; ++i) { u32x2 w; w.x = cvt_pk_bf16(v[q][i][0], v[q][i][1]); w.y = cvt_pk_bf16(v[q][i][2], v[q][i][3]); *(u32x2*)(xb + (size_t)(row0 + q) * 1024 + (lane + 64 * i) * 4) = w; } }
#pragma unroll
        for (int q = 0; q < 4; ++q) ss[q] = wave_sum(ss[q], lane);
        if (lane < 4) rstd1[row0 + lane] = rsqrtf((lane == 0 ? ss[0] : lane == 1 ? ss[1] : lane == 2 ? ss[2] : ss[3]) * (1.f / 1024.f) + EPS); }
    { float* ssum2 = (float*)(ws + WS_SSUM2); for (int i = bid * 512 + tid; i < M_TOK; i += nb * 512) ssum2[i] = 0.f; }
    float* cs = (float*)(ws + WS_ROPE); float* sn = cs + SEQ * 32;
    for (int idx = bid * 512 + tid; idx < SEQ * 32; idx += nb * 512) { const int pos = idx >> 5, i = idx & 31;
        const float inv = exp2f(-(float)i * (13.287712379549449f / 32.f)); const float ang = (float)pos * inv;
        const double rev = (double)ang * 0.15915494309189535; const float fr = (float)(rev - rint(rev));
        cs[idx] = __builtin_amdgcn_cosf(fr); sn[idx] = __builtin_amdgcn_sinf(fr); }
    if (bid == 0 && wave == 0) { const float d1 = wave_sum(p.lambda_q1[lane] * p.lambda_k1[lane], lane), d2 = wave_sum(p.lambda_q2[lane] * p.lambda_k2[lane], lane);
        if (lane == 0) ((float*)(ws + WS_MISC))[0] = expf(d1) - expf(d2) + 0.2f; }
}
DI void phase2(const Params& p, int wv) {
    int tid_ = fresh_tid<2>(wv); const int tid = tid_, bid = blockIdx.x, nb = gridDim.x, wave = tid >> 6, lane = tid & 63;
    unsigned char* ws = p.ws; bf16_t* P = (bf16_t*)(ws + WS_P); float* KR = (float*)(ws + WS_KR); float* rq = (float*)(ws + WS_RSTDQ); float* rkv = (float*)(ws + WS_RSTDKV); float* sskr_o = (float*)(ws + WS_SSKR);
    const float* cs = (const float*)(ws + WS_ROPE); const float* sn = cs + SEQ * 32;
    float gdq[8], gdk[8];
#pragma unroll
    for (int j = 0; j < 8; ++j) { gdq[j] = p.diff_q_norm_w[(lane & 7) * 8 + j] * (0.125f * LOG2E); gdk[j] = p.diff_k_norm_w[(lane & 7) * 8 + j]; }
    const int stride = nb * 8; int row = bid * 8 + wave;
    u32x2 cq_n; unsigned ckv_n; unsigned short kr_n; u32x4 dq_n, dk_n;
#define P2_LOAD(R) do { const bf16_t* pl_ = P + (size_t)(R) * 2048; cq_n = *(const u32x2*)(pl_ + lane * 4); ckv_n = *(const unsigned*)(pl_ + 256 + lane * 2); kr_n = pl_[384 + lane]; \
        dq_n = *(const u32x4*)(pl_ + 512 + lane * 8); dk_n = *(const u32x4*)(pl_ + 1024 + lane * 8); } while (0)
    if (row < M_TOK) P2_LOAD(row);
    for (; row < M_TOK; row += stride) { bf16_t* pr = P + (size_t)row * 2048;
        const u32x2 cq = cq_n; const unsigned ckv = ckv_n; const float kr = bf2f(kr_n); const u32x4 dq = dq_n, dk = dk_n;
        if (row + stride < M_TOK) P2_LOAD(row + stride);
        float a0 = __uint_as_float(cq.x << 16), a1 = __uint_as_float(cq.x & 0xffff0000u), a2 = __uint_as_float(cq.y << 16), a3 = __uint_as_float(cq.y & 0xffff0000u);
        float ssq = (a0 * a0 + a1 * a1) + (a2 * a2 + a3 * a3);
        float b0 = __uint_as_float(ckv << 16), b1 = __uint_as_float(ckv & 0xffff0000u); float sskv = b0 * b0 + b1 * b1;
        ssq = wave_sum(ssq, lane); sskv = wave_sum(sskv, lane); const float sskr = wave_sum(kr * kr, lane);
        const float partner = shx(kr, 32, lane); const int pos = row & (SEQ - 1), i = lane & 31; const float c = cs[pos * 32 + i], s = sn[pos * 32 + i];
        KR[(size_t)row * 64 + lane] = lane < 32 ? kr * c - partner * s : kr * c + partner * s;
        float fq_[8], fk_[8]; float sq = 0.f, sk = 0.f;
#pragma unroll
        for (int j = 0; j < 4; ++j) { fq_[2 * j] = __uint_as_float(dq[j] << 16); fq_[2 * j + 1] = __uint_as_float(dq[j] & 0xffff0000u); fk_[2 * j] = __uint_as_float(dk[j] << 16); fk_[2 * j + 1] = __uint_as_float(dk[j] & 0xffff0000u); }
#pragma unroll
        for (int j = 0; j < 8; ++j) { sq += fq_[j] * fq_[j]; sk += fk_[j] * fk_[j]; }
#pragma unroll
        for (int mk = 1; mk <= 4; mk <<= 1) { sq += shx(sq, mk, lane); sk += shx(sk, mk, lane); }
        const float rsq = rsqrtf(sq * (1.f / 64.f) + EPS), rsk = rsqrtf(sk * (1.f / 64.f) + EPS);
        u32x4 oq, ok;
#pragma unroll
        for (int j = 0; j < 4; ++j) { oq[j] = cvt_pk_bf16(fq_[2 * j] * rsq * gdq[2 * j], fq_[2 * j + 1] * rsq * gdq[2 * j + 1]); ok[j] = cvt_pk_bf16(fk_[2 * j] * rsk * gdk[2 * j], fk_[2 * j + 1] * rsk * gdk[2 * j + 1]); }
        *(u32x4*)(pr + 512 + lane * 8) = oq; *(u32x4*)(pr + 1024 + lane * 8) = ok;
        if (lane == 0) { rq[row] = rsqrtf(ssq * (1.f / 256.f) + EPS); rkv[row] = rsqrtf(sskv * (1.f / 128.f) + EPS); sskr_o[row] = sskr; } }
}
DI void phase3b(const Params& p, int wv) {
    int tid_ = fresh_tid<3>(wv); const int tid = tid_, bid = blockIdx.x, nb = gridDim.x, wave = tid >> 6, lane = tid & 63;
    unsigned char* ws = p.ws; bf16_t* KM = (bf16_t*)(ws + WS_KM); const float* KR = (const float*)(ws + WS_KR);
    const int hh = lane >> 4, d8 = (lane & 15) * 8; float g[8];
#pragma unroll
    for (int j = 0; j < 8; ++j) g[j] = p.mla_k_norm_w[d8 + j];
    const float gr = p.mla_k_norm_w[128 + lane];
    const int stride = nb * 8; int row = bid * 8 + wave; u32x4 kn_n; float r_n;
#define P3B_LOAD(R) do { kn_n = *(const u32x4*)(KM + (size_t)(R) * 768 + hh * 192 + d8); r_n = KR[(size_t)(R) * 64 + lane]; } while (0)
    if (row < M_TOK) P3B_LOAD(row);
    for (; row < M_TOK; row += stride) { bf16_t* kr_ = KM + (size_t)row * 768;
        const u32x4 kn = kn_n; const float r = r_n;
        if (row + stride < M_TOK) P3B_LOAD(row + stride);
        float f[8]; float ssn = 0.f;
#pragma unroll
        for (int j = 0; j < 4; ++j) { f[2 * j] = __uint_as_float(kn[j] << 16); f[2 * j + 1] = __uint_as_float(kn[j] & 0xffff0000u); }
#pragma unroll
        for (int j = 0; j < 8; ++j) ssn += f[j] * f[j];
#pragma unroll
        for (int mk = 1; mk <= 8; mk <<= 1) ssn += shx(ssn, mk, lane);
        const float ssr = wave_sum(r * r, lane);
        const float rstd = rsqrtf((ssn + ssr) * (1.f / 192.f) + EPS);
        u32x4 w;
#pragma unroll
        for (int j = 0; j < 4; ++j) w[j] = cvt_pk_bf16(f[2 * j] * rstd * g[2 * j], f[2 * j + 1] * rstd * g[2 * j + 1]);
        *(u32x4*)(kr_ + hh * 192 + d8) = w;
#pragma unroll
        for (int h2 = 0; h2 < 4; ++h2) { const float rh = shl_from(rstd, h2 * 16); kr_[h2 * 192 + 128 + lane] = f2bf(r * rh * gr); } }
}
DI void phase4(const Params& p, LAS unsigned char* lds, int wv) {
    unsigned char* ws = p.ws;
    const bf16_t* P = (const bf16_t*)(ws + WS_P); const bf16_t* Q = (const bf16_t*)(ws + WS_Q); const bf16_t* KM = (const bf16_t*)(ws + WS_KM); const bf16_t* V = (const bf16_t*)(ws + WS_V);
    bf16_t* AO = (bf16_t*)(ws + WS_AO); float* S0 = (float*)(ws + WS_S0); const float lam = ((const float*)(ws + WS_MISC))[0];
    for (int L = blockIdx.x; L < 2048; L += gridDim.x) {
        const int i = L >> 8, c = L & 255, x = c & 7, j = c >> 3, g = i * 8 + x, b = g >> 2, h = g & 3, kind = ((j >> 4) + i) & 1, qb = j & 15;
        const size_t rowbase = (size_t)b * SEQ, qrow = rowbase + qb * 256;
        if (kind == 0) {
            att::attn_body<192, 0, 768, 768, 512>(Q + qrow * 768 + h * 192, KM + rowbase * 768 + h * 192, V + rowbase * 512 + h * 128, qb * 256, 0.07216878364870322f * LOG2E,
                                                 p.mla_q_norm_w, nullptr, AO + qrow * 1024 + h * 128, 0.f, nullptr, lds, wv);
            __syncthreads();
        } else {
            LAS float* bt = (LAS float*)(lds + att::BT_OFF);
            const int tid = fresh_tid<4>(wv);
            if (tid < 449) { const int rel = tid - 224, n = rel < 0 ? -rel : rel;
                int lg = 8 + (n >= 12) + (n >= 16) + (n >= 23) + (n >= 32) + (n >= 46) + (n >= 64) + (n >= 91); const int bucket = (rel > 0 ? 16 : 0) + (n < 8 ? n : lg);
                bt[tid] = p.rel_bias[bucket * 4 + h] * LOG2E; }
            __syncthreads();
            att::attn_body<64, 1, 2048, 2048, 2048>(P + qrow * 2048 + 512 + h * 128, P + rowbase * 2048 + 1024 + h * 128, P + rowbase * 2048 + 1536 + h * 128, qb * 256, 0.f,
                                                   nullptr, S0 + qrow * 512 + h * 128, nullptr, 0.f, nullptr, lds, wv);
            __syncthreads();
            att::attn_body<64, 2, 2048, 2048, 2048>(P + qrow * 2048 + 512 + h * 128 + 64, P + rowbase * 2048 + 1024 + h * 128 + 64, P + rowbase * 2048 + 1536 + h * 128, qb * 256, 0.f,
                                                   nullptr, S0 + qrow * 512 + h * 128, AO + qrow * 1024 + 512 + h * 128, lam, p.diff_out_norm_w, lds, wv);
            __syncthreads();
        }
    }
}

constexpr int LDS_BYTES = 148 * 1024;
static_assert(att::ATT_LDS <= LDS_BYTES && pg8::STAGE_BYTES <= LDS_BYTES, "LDS must fit");
template <class Epi> DI void run_gemm(LAS unsigned char* lds, int wv, const bf16_t* A, int lda, const bf16_t* Bt, int N, int K, const Epi& E) {
    if (K <= 256) asm volatile("" : "+s"(K), "+s"(N), "+s"(lda));
    pg8::Gemm g{A, Bt, M_TOK, N, K, lda}; pg8::StaticOrder S; S.init(M_TOK, N, (int)gridDim.x, (int)blockIdx.x);
    pg8::gemm_phase<Epi, pg8::StaticOrder, true, true>(lds, g, S, E, wv);
}
template <int TAG> DI void fast_grid_sync(unsigned* cnt, int wv) {
    __syncthreads();
    if (wv == 0) {
        __builtin_amdgcn_fence(__ATOMIC_RELEASE, "agent");
        if ((fresh_tid<200 + TAG>(wv) & 63) == 0) {
            const unsigned G = gridDim.x, g = blockIdx.x & 7u, members = (G - g + 7u) >> 3, ngroups = G < 8u ? G : 8u;
            if (__hip_atomic_fetch_add(cnt + g * 32, 1u, __ATOMIC_RELAXED, __HIP_MEMORY_SCOPE_AGENT) == members - 1u)
                __hip_atomic_fetch_add(cnt + 8 * 32, 1u, __ATOMIC_RELAXED, __HIP_MEMORY_SCOPE_AGENT);
            while (__hip_atomic_load(cnt + 8 * 32, __ATOMIC_RELAXED, __HIP_MEMORY_SCOPE_AGENT) < ngroups) __builtin_amdgcn_s_sleep(1);
        }
        __builtin_amdgcn_fence(__ATOMIC_ACQUIRE, "agent");
    }
    __syncthreads();
}
__global__ void __launch_bounds__(512) fwd_kernel(Params p) {
    extern __shared__ __attribute__((aligned(16))) unsigned char lds_raw[];
    LAS unsigned char* lds = (LAS unsigned char*)lds_raw;
    cg::grid_group grid = cg::this_grid();
    const int wv = __builtin_amdgcn_readfirstlane(threadIdx.x >> 6);
    unsigned char* ws = p.ws; unsigned* bar = (unsigned*)(ws + WS_BAR);
    bf16_t* XB = (bf16_t*)(ws + WS_XB); bf16_t* P = (bf16_t*)(ws + WS_P); bf16_t* Q = (bf16_t*)(ws + WS_Q); bf16_t* KM = (bf16_t*)(ws + WS_KM); bf16_t* V = (bf16_t*)(ws + WS_V);
    bf16_t* U = (bf16_t*)(ws + WS_U); bf16_t* AO = (bf16_t*)(ws + WS_AO);
    float* ssq2 = (float*)(ws + WS_SSQ2); const float* cs = (const float*)(ws + WS_ROPE);
    phase0(p, lds, wv);
    fast_grid_sync<1>(bar + 2560, wv);
    if (p.ws == nullptr) grid.sync();
    { EpiProj E{P, (const float*)(ws + WS_RSTD1), (float*)(ws + WS_SSQ4), (float*)(ws + WS_SSKV4), (float*)(ws + WS_SSKR2), (float*)(ws + WS_KR), cs, cs + SEQ * 32, p.diff_q_norm_w, p.diff_k_norm_w}; run_gemm(lds, wv, XB, 1024, (const bf16_t*)(ws + WS_WIN), 2048, 1024, E); }
    fast_grid_sync<2>(bar + 0, wv);
    { EpiQ E{Q, (const float*)(ws + WS_SSQ4), cs, cs + SEQ * 32}; run_gemm(lds, wv, P, 2048, (const bf16_t*)(ws + WS_WUQ), 768, 256, E); }
    { EpiKV E{KM, V, (const float*)(ws + WS_SSKV4), (const float*)(ws + WS_KR), (const float*)(ws + WS_SSKR2), p.mla_k_norm_w, (LAS float*)(lds + pg8::STAGE_BYTES)}; run_gemm(lds, wv, P + 256, 2048, (const bf16_t*)(ws + WS_WUKV), 1024, 128, E); }
    fast_grid_sync<3>(bar + 512, wv);
    phase4(p, lds, wv);
    fast_grid_sync<4>(bar + 1024, wv);
    { EpiOut E{XB, (float*)(ws + WS_SSUM2)}; run_gemm(lds, wv, AO, 1024, (const bf16_t*)(ws + WS_WOUT), 1024, 1024, E); }
    fast_grid_sync<5>(bar + 1536, wv);
    { EpiUp E{U, (const float*)(ws + WS_SSUM2)}; run_gemm(lds, wv, XB, 1024, (const bf16_t*)(ws + WS_WUP), 4096, 1024, E); }
    fast_grid_sync<6>(bar + 2048, wv);
    { EpiDown E{p.out, XB}; run_gemm(lds, wv, U, 4096, (const bf16_t*)(ws + WS_WDN), 1024, 4096, E); }
}

extern "C" void kernel_launch(void* const* d_in, const int* in_sizes, int n_in, void* d_out, int out_size, void* d_ws, size_t ws_size, hipStream_t stream) {
    static int grid_blocks = 0;
    if (grid_blocks == 0) {
        if (n_in != 21 || in_sizes[0] != M_TOK * 1024 || out_size != M_TOK * 1024 || ws_size < WS_END) { fprintf(stderr, "kernel_launch: unexpected shapes (n_in %d, in0 %d, out %d, ws %zu)\n", n_in, n_in > 0 ? in_sizes[0] : -1, out_size, ws_size); grid_blocks = -1; return; }
        int dev = 0, cus = 0, per_cu = 0;
        hipGetDevice(&dev); hipDeviceGetAttribute(&cus, hipDeviceAttributeMultiprocessorCount, dev);
        if (hipFuncSetAttribute((const void*)fwd_kernel, hipFuncAttributeMaxDynamicSharedMemorySize, LDS_BYTES) != hipSuccess) { fprintf(stderr, "kernel_launch: hipFuncSetAttribute failed\n"); grid_blocks = -1; return; }
        if (hipOccupancyMaxActiveBlocksPerMultiprocessor(&per_cu, (const void*)fwd_kernel, 512, LDS_BYTES) != hipSuccess || per_cu < 1) { fprintf(stderr, "kernel_launch: occupancy query says %d\n", per_cu); per_cu = 1; }
        (void)hipGetLastError();
        grid_blocks = cus * 1;
    }
    if (grid_blocks < 0) return;
    Params p{};
    const float** pp = (const float**)&p;
    for (int i = 0; i < 21; ++i) pp[i] = (const float*)d_in[i];
    p.out = (float*)d_out; p.ws = (unsigned char*)d_ws;
    if (hipMemsetAsync((unsigned char*)d_ws + WS_BAR, 0, 16384, stream) != hipSuccess) { fprintf(stderr, "kernel_launch: hipMemsetAsync failed\n"); return; }
    void* args[] = {&p};
    hipError_t e = hipLaunchCooperativeKernel((const void*)fwd_kernel, dim3(grid_blocks), dim3(512), args, LDS_BYTES, stream);
    if (e != hipSuccess) fprintf(stderr, "cooperative launch failed: %s (grid %d)\n", hipGetErrorString(e), grid_blocks);
}
```

```cpp
#include <hip/hip_runtime.h>
#include <hip/hip_bf16.h>
#include <hip/hip_cooperative_groups.h>
#include <cstdio>
#include <cstdint>
namespace cg = cooperative_groups;
#define DI __device__ __forceinline__
#define LAS __attribute__((address_space(3)))
template <int TAG = 0> DI int fresh_tid(int wv) { int l; asm volatile("v_mbcnt_lo_u32_b32 %0, -1, 0\n\tv_mbcnt_hi_u32_b32 %0, -1, %0 ; site %1" : "=v"(l) : "n"(TAG)); return wv * 64 + l; }
namespace pg8 {
#define PG8_LAS __attribute__((address_space(3)))
typedef unsigned short bf16_t;
typedef short bf16x8 __attribute__((ext_vector_type(8)));
typedef float f32x4 __attribute__((ext_vector_type(4)));
typedef unsigned u32x4 __attribute__((ext_vector_type(4)));
constexpr int BM = 256, BK = 64, HALF = 128, HTB = HALF * BK * 2  , STAGE_BYTES = 8 * HTB, NXCD = 8, WGM = 8;

__host__ __device__ __forceinline__ int lds_byte(int r, int c) { const int st = (r >> 4) * 2 + (c >> 5), rr = r & 15, cc = c & 31, ob = rr * 64 + cc * 2; return st * 1024 + (ob ^ (((ob >> 9) & 1) << 5)); }
__host__ __device__ __forceinline__ void stage_rc(int b, int& R, int& C) { const int st = b / 1024, sb = b % 1024, swz = sb ^ (((sb >> 9) & 1) << 5); R = (st >> 1) * 16 + swz / 64; C = (st & 1) * 32 + (swz % 64) / 2; }
__host__ __device__ __forceinline__ int perm32(int rho) { const int n = rho >> 4, i = rho & 15; return 8 * (i >> 2) + 4 * n + (i & 3); }

struct Unit { int pm, pn; };
struct Gemm { const bf16_t* A; const bf16_t* Bt; int M, N, K, lda; };

struct StaticOrder {
    int nM, nN, nwg, G, c;
    __host__ __device__ void init(int M, int N, int G_, int c_) { nM = M / BM; nN = N / BM; nwg = nM * nN; G = G_; c = c_; }
    __host__ __device__ bool next(int i, Unit& u) const {
        const long L = (long)i * G + c; if (L >= nwg) return false;
        int wgid = (int)L; { const int q = nwg / NXCD, r = nwg % NXCD, xcd = wgid % NXCD, off = wgid / NXCD; wgid = (xcd < r ? xcd * (q + 1) : r * (q + 1) + (xcd - r) * q) + off; }
        const int nig = WGM * nN, gid = wgid / nig, fm = gid * WGM, gsz = (nM - fm) < WGM ? (nM - fm) : WGM;
        u.pm = fm + ((wgid % nig) % gsz); u.pn = (wgid % nig) / gsz; return true;
    }
    __device__ __forceinline__ void a_ready(const Unit&) const {}
    __device__ __forceinline__ void done(const Unit&) const {}
};

__device__ __forceinline__ unsigned cvt_pk_bf16(float lo, float hi) { unsigned r; asm volatile("v_cvt_pk_bf16_f32 %0, %1, %2" : "=v"(r) : "v"(lo), "v"(hi)); return r; }
typedef float f32x2 __attribute__((ext_vector_type(2)));
template <class Epi, class Sched, bool ALIGN_EPI = false, bool SP2 = false>
__device__ __forceinline__ void gemm_phase(PG8_LAS unsigned char* lds, const Gemm g, const Sched& S, const Epi& E, int wv) {
    int tid_ = fresh_tid<50>(wv); const int tid = tid_, wid = __builtin_amdgcn_readfirstlane(tid >> 6), lane = tid & 63, wr = wid >> 2, wc = wid & 3, fr = lane & 15, fq = lane >> 4;
    const int K = g.K, nt = K / BK;
    unsigned voffA[2], voffB[2];
#pragma unroll
    for (int i = 0; i < 2; ++i) { int R, C; stage_rc(tid * 16 + i * 8192, R, C); const int Rb = Epi::PERM ? ((R & ~31) + perm32(R & 31)) : R;
        voffA[i] = (unsigned)(R * g.lda + C) * 2u; voffB[i] = (unsigned)(Rb * K + C) * 2u; }
    const size_t kstep = (size_t)(BK * 2);
    const size_t hstepA = (size_t)HALF * g.lda * 2, hstepB = (size_t)HALF * K * 2;
    const size_t tstepA = 2 * hstepA, tstepB = 2 * hstepB;
    const unsigned ldsw = (unsigned)wid * 1024u;
    const int aoff = lds_byte(wr * 64 + fr, fq * 8), boff = lds_byte(wc * 32 + fr, fq * 8);
#define PG8_SA(b, h) (((b) * 2 + (h)) * HTB)
#define PG8_SB(b, h) ((4 + (b) * 2 + (h)) * HTB)
#define PG8_STAGE(bufoff, gbase, voff) do { _Pragma("unroll") for (int _i = 0; _i < 2; ++_i) \
        __builtin_amdgcn_global_load_lds((const unsigned*)((const char*)(gbase) + (voff)[_i]), (PG8_LAS unsigned*)(lds + (bufoff) + ldsw + _i * 8192), 16, 0, 0); } while (0)
#define PG8_LDA(dst, b, h) do { _Pragma("unroll") for (int m = 0; m < 4; ++m) _Pragma("unroll") for (int k = 0; k < 2; ++k) dst[m][k] = *(const PG8_LAS bf16x8*)(lds + PG8_SA(b, h) + aoff + m * 2048 + k * 1024); } while (0)
#define PG8_LDB(dst, b, h) do { _Pragma("unroll") for (int n = 0; n < 2; ++n) _Pragma("unroll") for (int k = 0; k < 2; ++k) dst[n][k] = *(const PG8_LAS bf16x8*)(lds + PG8_SB(b, h) + boff + n * 2048 + k * 1024); } while (0)
#define PG8_MMA(ai, bj, At, Bt) do { __builtin_amdgcn_s_setprio(1); _Pragma("unroll") for (int m = 0; m < 4; ++m) _Pragma("unroll") for (int n = 0; n < 2; ++n) _Pragma("unroll") for (int k = 0; k < 2; ++k) \
        acc[ai][bj][m][n] = __builtin_amdgcn_mfma_f32_16x16x32_bf16(Bt[n][k], At[m][k], acc[ai][bj][m][n], 0, 0, 0); __builtin_amdgcn_s_setprio(0); } while (0)
#define PG8_WAIT_V(n) asm volatile("s_waitcnt vmcnt(" #n ")" ::: "memory")
#define PG8_WAIT_L(n) asm volatile("s_waitcnt lgkmcnt(" #n ")" ::: "memory")
#define PG8_BAR __builtin_amdgcn_s_barrier()
#define PG8_SCHED __builtin_amdgcn_sched_barrier(0)
    Unit cur, nxt; int ui = 0;
    if (!S.next(0, cur)) return;
    f32x4 acc[2][2][4][2];
#pragma unroll
    for (int a = 0; a < 2; ++a)
#pragma unroll
        for (int b = 0; b < 2; ++b)
#pragma unroll
            for (int m = 0; m < 4; ++m)
#pragma unroll
                for (int n = 0; n < 2; ++n) acc[a][b][m][n] = (f32x4){0.f, 0.f, 0.f, 0.f};
    bf16x8 At[4][2], B0[2][2], B1[2][2];
    const char* cA = (const char*)g.A + (size_t)cur.pm * tstepA; const char* cB = (const char*)g.Bt + (size_t)cur.pn * tstepB;
    S.a_ready(cur);
    if constexpr (SP2) {
        PG8_STAGE(PG8_SB(0, 0), cB, voffB); PG8_STAGE(PG8_SB(0, 1), cB + hstepB, voffB); PG8_STAGE(PG8_SA(0, 0), cA, voffA); PG8_STAGE(PG8_SA(0, 1), cA + hstepA, voffA);
        if (wr == 1) PG8_BAR;
        PG8_WAIT_V(2); PG8_BAR;
        PG8_STAGE(PG8_SB(1, 0), cB + kstep, voffB); PG8_STAGE(PG8_SA(1, 0), cA + kstep, voffA); PG8_STAGE(PG8_SB(1, 1), cB + hstepB + kstep, voffB);
        PG8_WAIT_V(6); PG8_BAR;
    } else {
        PG8_STAGE(PG8_SB(0, 0), cB, voffB); PG8_STAGE(PG8_SA(0, 0), cA, voffA); PG8_STAGE(PG8_SB(0, 1), cB + hstepB, voffB); PG8_STAGE(PG8_SA(0, 1), cA + hstepA, voffA);
        if (wr == 1) PG8_BAR;
        PG8_WAIT_V(4); PG8_BAR;
        PG8_STAGE(PG8_SB(1, 0), cB + kstep, voffB); PG8_STAGE(PG8_SA(1, 0), cA + kstep, voffA); PG8_STAGE(PG8_SB(1, 1), cB + hstepB + kstep, voffB);
        PG8_WAIT_V(6); PG8_BAR;
    }
    for (;;) {
        const bool has_next = S.next(ui + 1, nxt);
        const char* nA = has_next ? (const char*)g.A + (size_t)nxt.pm * tstepA : cA; const char* nB = has_next ? (const char*)g.Bt + (size_t)nxt.pn * tstepB : cB;
        for (int t = 0; t < nt; t += 2) {
            const bool last = (t == nt - 2);
            const char* a1 = cA + (size_t)(t + 1) * kstep;
            const char* a2 = last ? nA : cA + (size_t)(t + 2) * kstep; const char* b2 = last ? nB : cB + (size_t)(t + 2) * kstep;
            const char* a3 = a2 + kstep; const char* b3 = b2 + kstep;
            if (last && has_next) S.a_ready(nxt);
            if constexpr (SP2) {
            PG8_LDB(B0, 0, 0); PG8_LDB(B1, 0, 1); PG8_SCHED; PG8_LDA(At, 0, 0); PG8_STAGE(PG8_SA(1, 1), a1 + hstepA, voffA);
            PG8_WAIT_V(8); PG8_WAIT_L(0); PG8_BAR; PG8_MMA(0, 0, At, B0); PG8_MMA(0, 1, At, B1); PG8_BAR; PG8_SCHED;
            PG8_LDA(At, 0, 1); PG8_STAGE(PG8_SB(0, 0), b2, voffB); PG8_STAGE(PG8_SB(0, 1), b2 + hstepB, voffB); PG8_STAGE(PG8_SA(0, 0), a2, voffA);
            PG8_WAIT_V(8); PG8_WAIT_L(0); PG8_BAR; PG8_MMA(1, 0, At, B0); PG8_MMA(1, 1, At, B1); PG8_BAR; PG8_SCHED;
            PG8_LDB(B0, 1, 0); PG8_LDB(B1, 1, 1); PG8_SCHED; PG8_LDA(At, 1, 0); PG8_STAGE(PG8_SA(0, 1), a2 + hstepA, voffA);
            PG8_WAIT_V(8); PG8_WAIT_L(0); PG8_BAR; PG8_MMA(0, 0, At, B0); PG8_MMA(0, 1, At, B1); PG8_BAR; PG8_SCHED;
            PG8_LDA(At, 1, 1); PG8_STAGE(PG8_SB(1, 0), b3, voffB); PG8_STAGE(PG8_SB(1, 1), b3 + hstepB, voffB); PG8_STAGE(PG8_SA(1, 0), a3, voffA);
            PG8_WAIT_V(8); PG8_WAIT_L(0); PG8_BAR; PG8_MMA(1, 0, At, B0); PG8_MMA(1, 1, At, B1); PG8_BAR; PG8_SCHED;
            } else {
            PG8_LDB(B0, 0, 0); PG8_SCHED; PG8_LDA(At, 0, 0); PG8_STAGE(PG8_SA(1, 1), a1 + hstepA, voffA);
            PG8_WAIT_L(8); PG8_BAR; PG8_WAIT_L(0); PG8_MMA(0, 0, At, B0); PG8_BAR; PG8_SCHED;
            PG8_LDB(B1, 0, 1); PG8_STAGE(PG8_SB(0, 0), b2, voffB);
            PG8_BAR; PG8_WAIT_L(0); PG8_MMA(0, 1, At, B1); PG8_BAR;
            PG8_LDA(At, 0, 1); PG8_STAGE(PG8_SA(0, 0), a2, voffA);
            PG8_BAR; PG8_WAIT_L(0); PG8_MMA(1, 0, At, B0); PG8_BAR; PG8_SCHED;
            PG8_STAGE(PG8_SB(0, 1), b2 + hstepB, voffB);
            PG8_WAIT_V(6); PG8_BAR; PG8_MMA(1, 1, At, B1); PG8_BAR;
            PG8_LDB(B0, 1, 0); PG8_SCHED; PG8_LDA(At, 1, 0); PG8_STAGE(PG8_SA(0, 1), a2 + hstepA, voffA);
            PG8_WAIT_L(8); PG8_BAR; PG8_WAIT_L(0); PG8_MMA(0, 0, At, B0); PG8_BAR; PG8_SCHED;
            PG8_LDB(B1, 1, 1); PG8_STAGE(PG8_SB(1, 0), b3, voffB);
            PG8_BAR; PG8_WAIT_L(0); PG8_MMA(0, 1, At, B1); PG8_BAR;
            PG8_LDA(At, 1, 1); PG8_STAGE(PG8_SA(1, 0), a3, voffA);
            PG8_BAR; PG8_WAIT_L(0); PG8_MMA(1, 0, At, B0); PG8_BAR; PG8_SCHED;
            PG8_STAGE(PG8_SB(1, 1), b3 + hstepB, voffB);
            PG8_WAIT_V(6); PG8_BAR; PG8_MMA(1, 1, At, B1); PG8_BAR;
            }
        }
        if constexpr (ALIGN_EPI) { if (wr == 0) PG8_BAR; }
        if constexpr (!Epi::AFTER_DRAIN) { E(acc, cur, wr, wc, fr, fq); S.done(cur); }
        if (!has_next) break;
#pragma unroll
        for (int a = 0; a < 2; ++a)
#pragma unroll
            for (int b = 0; b < 2; ++b)
#pragma unroll
                for (int m = 0; m < 4; ++m)
#pragma unroll
                    for (int n = 0; n < 2; ++n) acc[a][b][m][n] = (f32x4){0.f, 0.f, 0.f, 0.f};
        cur = nxt; cA = nA; cB = nB; ++ui;
        if constexpr (ALIGN_EPI) { if (wr == 1) PG8_BAR; }
    }
    PG8_WAIT_V(0);
    if constexpr (!ALIGN_EPI) { if (wr == 0) PG8_BAR; }
    PG8_BAR;
    if constexpr (Epi::AFTER_DRAIN) { E.fused(acc, cur, wr, wc, fr, fq, lds, wid, lane); S.done(cur); }
#undef PG8_SA
#undef PG8_SB
#undef PG8_STAGE
#undef PG8_LDA
#undef PG8_LDB
#undef PG8_MMA
#undef PG8_WAIT_V
#undef PG8_WAIT_L
#undef PG8_BAR
#undef PG8_SCHED
}
}
using pg8::bf16_t; using pg8::f32x4; using pg8::u32x4; using pg8::Unit; using pg8::cvt_pk_bf16;
typedef unsigned u32x2 __attribute__((ext_vector_type(2)));
constexpr int M_TOK = 65536, SEQ = 4096;
constexpr float EPS = 1e-6f, LOG2E = 1.4426950408889634f;
constexpr size_t MiB = 1ull << 20;
constexpr size_t WS_XB = 0, WS_P = 128 * MiB, WS_Q = 384 * MiB, WS_KM = 480 * MiB, WS_V = 576 * MiB, WS_U = 128 * MiB, WS_AO = 640 * MiB, WS_KR = 768 * MiB,
                 WS_WIN = 784 * MiB, WS_WUQ = 788 * MiB, WS_WUKV = 789 * MiB, WS_WOUT = 790 * MiB, WS_WUP = 792 * MiB, WS_WDN = 800 * MiB,
                 WS_RSTD1 = 808 * MiB, WS_RSTDQ = WS_RSTD1 + 256 * 1024, WS_RSTDKV = WS_RSTDQ + 256 * 1024, WS_SSKR = WS_RSTDKV + 256 * 1024, WS_ROPE = 809 * MiB, WS_SSQ2 = 810 * MiB,
                 WS_MISC = 814 * MiB, WS_SSUM2 = WS_MISC + 64 * 1024, WS_SSQ4 = 815 * MiB, WS_SSKV4 = 816 * MiB, WS_SSKR2 = 817 * MiB, WS_S0 = 832 * MiB, WS_BAR = 960 * MiB, WS_END = 961 * MiB;
struct Params {
    const float *x, *attn_norm_w, *w_in, *q_a_norm_w, *w_uq, *kv_a_norm_w, *w_ukv, *mla_q_norm_w, *mla_k_norm_w, *diff_q_norm_w, *diff_k_norm_w,
                *lambda_q1, *lambda_k1, *lambda_q2, *lambda_k2, *diff_out_norm_w, *w_out, *mlp_norm_w, *w_up, *w_down, *rel_bias;
    float* out; unsigned char* ws;
};
DI float bf2f(unsigned short h) { return __uint_as_float((unsigned)h << 16); }
DI unsigned short f2bf(float x) { unsigned u = __float_as_uint(x); u += 0x7fffu + ((u >> 16) & 1u); return (unsigned short)(u >> 16); }
DI float shx(float v, int mask, int lane) { return __int_as_float(__builtin_amdgcn_ds_bpermute((lane ^ mask) << 2, __float_as_int(v))); }
DI float shl_from(float v, int src) { return __int_as_float(__builtin_amdgcn_ds_bpermute(src << 2, __float_as_int(v))); }
DI float wave_sum(float v, int lane) {
#pragma unroll
    for (int m = 32; m >= 1; m >>= 1) v += shx(v, m, lane);
    return v;
}

struct EpiProj {
    static constexpr bool PERM = true, AFTER_DRAIN = false;
    bf16_t* O; const float* rs; float* ssq4; float* sskv4; float* sskr2; float* KR; const float* cs; const float* sn; const float* gdq; const float* gdk;
    DI void operator()(const f32x4 (&acc)[2][2][4][2], const Unit& u, int wr, int wc, int fr, int fq) const {
        const int row0 = u.pm * 256 + wr * 64 + fr, pn = u.pn, ln = fq * 16 + fr;
        if (pn >= 2 && pn < 6) {
            const float* gp = pn < 4 ? gdq : gdk; const float gsc = pn < 4 ? 0.125f * LOG2E : 1.f;
            f32x4 g[2][2];
#pragma unroll
            for (int bj = 0; bj < 2; ++bj)
#pragma unroll
                for (int n = 0; n < 2; ++n) g[bj][n] = *(const f32x4*)(gp + 32 * bj + 8 * fq + 4 * n) * gsc;
#pragma unroll
            for (int ai = 0; ai < 2; ++ai)
#pragma unroll
                for (int m = 0; m < 4; ++m) { const int row = row0 + ai * 128 + m * 16; const float s = rs[row]; float ss = 0.f;
#pragma unroll
                    for (int bj = 0; bj < 2; ++bj)
#pragma unroll
                        for (int n = 0; n < 2; ++n) { const f32x4 v = acc[ai][bj][m][n]; ss += (v[0] * v[0] + v[1] * v[1]) + (v[2] * v[2] + v[3] * v[3]); }
                    ss += shx(ss, 16, ln); ss += shx(ss, 32, ln);
                    const float r = s * rsqrtf(ss * s * s * (1.f / 64.f) + EPS);
                    bf16_t* rowp = O + (size_t)row * 2048 + pn * 256 + 64 * wc + 8 * fq;
#pragma unroll
                    for (int bj = 0; bj < 2; ++bj) { const f32x4 v0 = acc[ai][bj][m][0] * r * g[bj][0], v1 = acc[ai][bj][m][1] * r * g[bj][1]; u32x4 w;
                        w.x = cvt_pk_bf16(v0[0], v0[1]); w.y = cvt_pk_bf16(v0[2], v0[3]); w.z = cvt_pk_bf16(v1[0], v1[1]); w.w = cvt_pk_bf16(v1[2], v1[3]);
                        *(u32x4*)(rowp + 32 * bj) = w; } }
            return;
        }
        const int col0 = pn * 256 + wc * 32 + 8 * fq;
#pragma unroll
        for (int ai = 0; ai < 2; ++ai)
#pragma unroll
            for (int m = 0; m < 4; ++m) { const int row = row0 + ai * 128 + m * 16; const float s = rs[row]; bf16_t* rowp = O + (size_t)row * 2048 + col0;
                f32x4 v[2][2];
#pragma unroll
                for (int bj = 0; bj < 2; ++bj) { v[bj][0] = acc[ai][bj][m][0] * s; v[bj][1] = acc[ai][bj][m][1] * s; u32x4 w;
                    w.x = cvt_pk_bf16(v[bj][0][0], v[bj][0][1]); w.y = cvt_pk_bf16(v[bj][0][2], v[bj][0][3]); w.z = cvt_pk_bf16(v[bj][1][0], v[bj][1][1]); w.w = cvt_pk_bf16(v[bj][1][2], v[bj][1][3]);
                    *(u32x4*)(rowp + bj * 128) = w; }
                if (pn < 2) {
                    float s0 = 0.f, s1 = 0.f;
#pragma unroll
                    for (int n = 0; n < 2; ++n) { s0 += (v[0][n][0] * v[0][n][0] + v[0][n][1] * v[0][n][1]) + (v[0][n][2] * v[0][n][2] + v[0][n][3] * v[0][n][3]);
                                                  s1 += (v[1][n][0] * v[1][n][0] + v[1][n][1] * v[1][n][1]) + (v[1][n][2] * v[1][n][2] + v[1][n][3] * v[1][n][3]); }
                    if (pn == 0) { float ss = s0 + s1; ss += shx(ss, 16, ln); ss += shx(ss, 32, ln); if (fq == 0) ssq4[(size_t)row * 4 + wc] = ss; }
                    else { s0 += shx(s0, 16, ln); s0 += shx(s0, 32, ln); if (fq == 0) sskv4[(size_t)row * 4 + wc] = s0;
                        if (wc < 2) { s1 += shx(s1, 16, ln); s1 += shx(s1, 32, ln); if (fq == 0) sskr2[(size_t)row * 2 + wc] = s1;
                            const int i0 = 16 * wc + 4 * fq, pos = row & (SEQ - 1); const f32x4 c = *(const f32x4*)(cs + pos * 32 + i0), sv = *(const f32x4*)(sn + pos * 32 + i0);
                            *(f32x4*)(KR + (size_t)row * 64 + i0) = v[1][0] * c - v[1][1] * sv; *(f32x4*)(KR + (size_t)row * 64 + 32 + i0) = v[1][1] * c + v[1][0] * sv; } } } }
    }
};
struct EpiQ {
    static constexpr bool PERM = true, AFTER_DRAIN = false;
    bf16_t* Q; const float* ssq4; const float* cs; const float* sn;
    DI void operator()(const f32x4 (&acc)[2][2][4][2], const Unit& u, int wr, int wc, int fr, int fq) const {
        const int row0 = u.pm * 256 + wr * 64 + fr;
#pragma unroll
        for (int ai = 0; ai < 2; ++ai)
#pragma unroll
            for (int m = 0; m < 4; ++m) { const int row = row0 + ai * 128 + m * 16; const f32x4 q4 = *(const f32x4*)(ssq4 + (size_t)row * 4);
                const float s = rsqrtf(((q4[0] + q4[1]) + (q4[2] + q4[3])) * (1.f / 256.f) + EPS); bf16_t* rowp = Q + (size_t)row * 768;
#pragma unroll
                for (int bj = 0; bj < 2; ++bj) { const int c0 = u.pn * 256 + bj * 128 + wc * 32, h = c0 / 192, d0 = c0 - h * 192;
                    if (d0 < 128) { const f32x4 v0 = acc[ai][bj][m][0] * s, v1 = acc[ai][bj][m][1] * s; u32x4 w;
                        w.x = cvt_pk_bf16(v0[0], v0[1]); w.y = cvt_pk_bf16(v0[2], v0[3]); w.z = cvt_pk_bf16(v1[0], v1[1]); w.w = cvt_pk_bf16(v1[2], v1[3]);
                        *(u32x4*)(rowp + c0 + 8 * fq) = w; }
                    else { const int i0 = 16 * (wc & 1) + 4 * fq, pos = row & (SEQ - 1);
                        const f32x4 c = *(const f32x4*)(cs + pos * 32 + i0), sv = *(const f32x4*)(sn + pos * 32 + i0);
                        const f32x4 x1 = acc[ai][bj][m][0] * s, x2 = acc[ai][bj][m][1] * s; const f32x4 o1 = x1 * c - x2 * sv, o2 = x2 * c + x1 * sv; u32x2 a, b;
                        a.x = cvt_pk_bf16(o1[0], o1[1]); a.y = cvt_pk_bf16(o1[2], o1[3]); b.x = cvt_pk_bf16(o2[0], o2[1]); b.y = cvt_pk_bf16(o2[2], o2[3]);
                        *(u32x2*)(rowp + h * 192 + 128 + i0) = a; *(u32x2*)(rowp + h * 192 + 160 + i0) = b; } } }
    }
};
struct EpiKV {
    static constexpr bool PERM = true, AFTER_DRAIN = false;
    bf16_t* KM; bf16_t* V; const float* sskv4; const float* KR; const float* sskr2; const float* gk; LAS float* part;
    DI float rsrow(int row) const { const f32x4 q4 = *(const f32x4*)(sskv4 + (size_t)row * 4); return rsqrtf(((q4[0] + q4[1]) + (q4[2] + q4[3])) * (1.f / 128.f) + EPS); }
    DI void operator()(const f32x4 (&acc)[2][2][4][2], const Unit& u, int wr, int wc, int fr, int fq) const {
        const int row0 = u.pm * 256 + wr * 64 + fr, h = u.pn, cw = wc * 32 + 8 * fq, ln = fq * 16 + fr;
#pragma unroll
        for (int ai = 0; ai < 2; ++ai)
#pragma unroll
            for (int m = 0; m < 4; ++m) { const int row = row0 + ai * 128 + m * 16; const float s = rsrow(row);
                const f32x4 w0 = acc[ai][1][m][0] * s, w1 = acc[ai][1][m][1] * s; u32x4 w;
                w.x = cvt_pk_bf16(w0[0], w0[1]); w.y = cvt_pk_bf16(w0[2], w0[3]); w.z = cvt_pk_bf16(w1[0], w1[1]); w.w = cvt_pk_bf16(w1[2], w1[3]);
                *(u32x4*)(V + (size_t)row * 512 + h * 128 + cw) = w; }
        asm volatile("" ::: "memory");
#pragma unroll
        for (int ai = 0; ai < 2; ++ai)
#pragma unroll
            for (int m = 0; m < 4; ++m) { const int row = row0 + ai * 128 + m * 16; const float s = rsrow(row);
                const f32x4 v0 = acc[ai][0][m][0] * s, v1 = acc[ai][0][m][1] * s;
                float ss = ((v0[0] * v0[0] + v0[1] * v0[1]) + (v0[2] * v0[2] + v0[3] * v0[3])) + ((v1[0] * v1[0] + v1[1] * v1[1]) + (v1[2] * v1[2] + v1[3] * v1[3]));
                ss += shx(ss, 16, ln); ss += shx(ss, 32, ln);
                if (fq == 0) part[(ai * 128 + wr * 64 + m * 16 + fr) * 4 + wc] = ss; }
        asm volatile("s_waitcnt lgkmcnt(0)" ::: "memory"); __builtin_amdgcn_s_barrier(); asm volatile("" ::: "memory");
#pragma unroll
        for (int ai = 0; ai < 2; ++ai)
#pragma unroll
            for (int m = 0; m < 4; ++m) { const int row = row0 + ai * 128 + m * 16; const f32x4 pp = *(const LAS f32x4*)(part + (ai * 128 + wr * 64 + m * 16 + fr) * 4);
                const float rstd = rsqrtf((((pp[0] + pp[1]) + (pp[2] + pp[3])) + (sskr2[(size_t)row * 2] + sskr2[(size_t)row * 2 + 1])) * (1.f / 192.f) + EPS), s = rsrow(row) * rstd;
                const f32x4 g0 = *(const f32x4*)(gk + cw), g1 = *(const f32x4*)(gk + cw + 4), gr = *(const f32x4*)(gk + 128 + wc * 16 + fq * 4);
                const f32x4 v0 = acc[ai][0][m][0] * s * g0, v1 = acc[ai][0][m][1] * s * g1; u32x4 w;
                w.x = cvt_pk_bf16(v0[0], v0[1]); w.y = cvt_pk_bf16(v0[2], v0[3]); w.z = cvt_pk_bf16(v1[0], v1[1]); w.w = cvt_pk_bf16(v1[2], v1[3]);
                bf16_t* kp = KM + (size_t)row * 768 + h * 192;
                *(u32x4*)(kp + cw) = w;
                const f32x4 kr = *(const f32x4*)(KR + (size_t)row * 64 + wc * 16 + fq * 4) * rstd * gr; u32x2 r2; r2.x = cvt_pk_bf16(kr[0], kr[1]); r2.y = cvt_pk_bf16(kr[2], kr[3]);
                *(u32x2*)(kp + 128 + wc * 16 + fq * 4) = r2; asm volatile("" ::: "memory"); }
    }
};
struct EpiOut {
    static constexpr bool PERM = true, AFTER_DRAIN = false;
    bf16_t* x1b; float* ssum2;
    DI void operator()(const f32x4 (&acc)[2][2][4][2], const Unit& u, int wr, int wc, int fr, int fq) const {
        const int row0 = u.pm * 256 + wr * 64 + fr, col0 = u.pn * 256 + wc * 32 + 8 * fq;
#pragma unroll
        for (int ai = 0; ai < 2; ++ai)
#pragma unroll
            for (int m = 0; m < 4; ++m) { const int row = row0 + ai * 128 + m * 16; const size_t off = (size_t)row * 1024 + col0; float ss = 0.f;
#pragma unroll
                for (int bj = 0; bj < 2; ++bj) { const size_t o = off + bj * 128; const u32x4 r_ = *(const u32x4*)(x1b + o); f32x4 v0, v1;
                    v0[0] = __uint_as_float(r_.x << 16); v0[1] = __uint_as_float(r_.x & 0xffff0000u); v0[2] = __uint_as_float(r_.y << 16); v0[3] = __uint_as_float(r_.y & 0xffff0000u);
                    v1[0] = __uint_as_float(r_.z << 16); v1[1] = __uint_as_float(r_.z & 0xffff0000u); v1[2] = __uint_as_float(r_.w << 16); v1[3] = __uint_as_float(r_.w & 0xffff0000u);
                    v0 = v0 + acc[ai][bj][m][0]; v1 = v1 + acc[ai][bj][m][1];
                    ss += ((v0[0] * v0[0] + v0[1] * v0[1]) + (v0[2] * v0[2] + v0[3] * v0[3])) + ((v1[0] * v1[0] + v1[1] * v1[1]) + (v1[2] * v1[2] + v1[3] * v1[3]));
                    u32x4 w; w.x = cvt_pk_bf16(v0[0], v0[1]); w.y = cvt_pk_bf16(v0[2], v0[3]); w.z = cvt_pk_bf16(v1[0], v1[1]); w.w = cvt_pk_bf16(v1[2], v1[3]); *(u32x4*)(x1b + o) = w; }
                { const int ln_ = fq * 16 + fr; ss += shx(ss, 16, ln_); ss += shx(ss, 32, ln_); }
                if (fq == 0) unsafeAtomicAdd(ssum2 + row, ss); }
    }
};
struct EpiUp {
    static constexpr bool PERM = true, AFTER_DRAIN = false;
    bf16_t* U; const float* ssum2;
    DI void operator()(const f32x4 (&acc)[2][2][4][2], const Unit& u, int wr, int wc, int fr, int fq) const {
        const int row0 = u.pm * 256 + wr * 64 + fr, col0 = u.pn * 256 + wc * 32 + 8 * fq;
#pragma unroll
        for (int ai = 0; ai < 2; ++ai)
#pragma unroll
            for (int m = 0; m < 4; ++m) { const int row = row0 + ai * 128 + m * 16; const float s = rsqrtf(ssum2[row] * (1.f / 1024.f) + EPS);
                bf16_t* rowp = U + (size_t)row * 4096 + col0;
#pragma unroll
                for (int bj = 0; bj < 2; ++bj) { f32x4 v0 = acc[ai][bj][m][0] * s, v1 = acc[ai][bj][m][1] * s;
#pragma unroll
                    for (int j = 0; j < 4; ++j) { const float a = fmaxf(v0[j], 0.f), b = fmaxf(v1[j], 0.f); v0[j] = a * a; v1[j] = b * b; }
                    u32x4 w; w.x = cvt_pk_bf16(v0[0], v0[1]); w.y = cvt_pk_bf16(v0[2], v0[3]); w.z = cvt_pk_bf16(v1[0], v1[1]); w.w = cvt_pk_bf16(v1[2], v1[3]);
                    __builtin_nontemporal_store(w, (u32x4*)(rowp + bj * 128)); } }
    }
};
struct EpiDown {
    static constexpr bool PERM = true, AFTER_DRAIN = false;
    float* out; const bf16_t* x1b;
    DI void operator()(const f32x4 (&acc)[2][2][4][2], const Unit& u, int wr, int wc, int fr, int fq) const {
        const int row0 = u.pm * 256 + wr * 64 + fr, col0 = u.pn * 256 + wc * 32 + 8 * fq;
#pragma unroll
        for (int ai = 0; ai < 2; ++ai)
#pragma unroll
            for (int m = 0; m < 4; ++m) { const size_t off = (size_t)(row0 + ai * 128 + m * 16) * 1024 + col0;
#pragma unroll
                for (int bj = 0; bj < 2; ++bj) { const size_t o = off + bj * 128; const u32x4 r = *(const u32x4*)(x1b + o); f32x4 v0, v1;
                    v0[0] = __uint_as_float(r.x << 16); v0[1] = __uint_as_float(r.x & 0xffff0000u); v0[2] = __uint_as_float(r.y << 16); v0[3] = __uint_as_float(r.y & 0xffff0000u);
                    v1[0] = __uint_as_float(r.z << 16); v1[1] = __uint_as_float(r.z & 0xffff0000u); v1[2] = __uint_as_float(r.w << 16); v1[3] = __uint_as_float(r.w & 0xffff0000u);
                    __builtin_nontemporal_store(v0 + acc[ai][bj][m][0], (f32x4*)(out + o)); __builtin_nontemporal_store(v1 + acc[ai][bj][m][1], (f32x4*)(out + o + 4)); } }
    }
};
namespace att {
typedef short bf16x8 __attribute__((ext_vector_type(8)));
typedef short s16x4 __attribute__((ext_vector_type(4)));
typedef float f32x16 __attribute__((ext_vector_type(16)));
constexpr int SHM_V = 16384, KBUF_MAX = 64 * 192 * 2, V_OFF = 4 * KBUF_MAX, WS_OFF = V_OFF + 3 * SHM_V, BT_OFF = WS_OFF + 8 * 64 * 4, ATT_LDS = BT_OFF + 1800;
#define SBAR() __builtin_amdgcn_sched_barrier(0)
DI int crow(int r, int hi) { return (r & 3) + 8 * (r >> 2) + 4 * hi; }
DI unsigned cvtpk(float lo, float hi) { unsigned r; asm volatile("v_cvt_pk_bf16_f32 %0, %1, %2" : "=v"(r) : "v"(lo), "v"(hi)); return r; }
template <int DQK> DI int kswz(int row, int colB) { return row * (DQK * 2) + (colB ^ (((row >> 1) & 7) << 4)); }
DI float swap_sum(float v) { auto rr = __builtin_amdgcn_permlane32_swap(__float_as_uint(v), __float_as_uint(v), false, false); return __uint_as_float(rr[0]) + __uint_as_float(rr[1]); }

DI void expsum(f32x16& p, float& l_reg, bf16x8& pa0, bf16x8& pa1) {
#pragma unroll
    for (int r = 0; r < 16; ++r) p[r] = __builtin_amdgcn_exp2f(p[r]);
    float ps = 0.f;
#pragma unroll
    for (int r = 0; r < 16; ++r) ps += p[r];
    l_reg += ps; asm volatile("" : "+v"(l_reg));
#define ATT_PK4(P, BASE, OUT) do { unsigned a0 = cvtpk(P[BASE + 0], P[BASE + 1]), a1 = cvtpk(P[BASE + 2], P[BASE + 3]);   \
    unsigned b0 = cvtpk(P[BASE + 4], P[BASE + 5]), b1 = cvtpk(P[BASE + 6], P[BASE + 7]);                              \
    auto r0 = __builtin_amdgcn_permlane32_swap(a0, b0, false, false); auto r1 = __builtin_amdgcn_permlane32_swap(a1, b1, false, false); \
    u32x4 w = {r0[0], r1[0], r0[1], r1[1]}; OUT = __builtin_bit_cast(bf16x8, w); } while (0)
    ATT_PK4(p, 0, pa0); ATT_PK4(p, 8, pa1);
#undef ATT_PK4
}
DI int v_rd_base(int lane) { return ((lane & 3) << 3) | (((lane >> 2) & 3) << 6) | (((lane >> 4) & 1) << 5) | (((lane >> 5) & 1) << 8); }
constexpr int v_rd_off(int d0, int ks, int half) { return d0 * 512 + ks * 4096 + half * 2048; }
template <int OFF> DI s16x4 tr_read(int vb) { s16x4 r; asm volatile("ds_read_b64_tr_b16 %0, %1 offset:%2" : "=&v"(r) : "v"(vb), "i"(OFF) : "memory"); return r; }
template <int H> DI void v_reads(s16x4* vf, int vb) {
    vf[0] = tr_read<v_rd_off(0, 2 * H, 0)>(vb); vf[1] = tr_read<v_rd_off(0, 2 * H, 1)>(vb); vf[2] = tr_read<v_rd_off(0, 2 * H + 1, 0)>(vb); vf[3] = tr_read<v_rd_off(0, 2 * H + 1, 1)>(vb);
    vf[4] = tr_read<v_rd_off(1, 2 * H, 0)>(vb); vf[5] = tr_read<v_rd_off(1, 2 * H, 1)>(vb); vf[6] = tr_read<v_rd_off(1, 2 * H + 1, 0)>(vb); vf[7] = tr_read<v_rd_off(1, 2 * H + 1, 1)>(vb);
    vf[8] = tr_read<v_rd_off(2, 2 * H, 0)>(vb); vf[9] = tr_read<v_rd_off(2, 2 * H, 1)>(vb); vf[10] = tr_read<v_rd_off(2, 2 * H + 1, 0)>(vb); vf[11] = tr_read<v_rd_off(2, 2 * H + 1, 1)>(vb);
    vf[12] = tr_read<v_rd_off(3, 2 * H, 0)>(vb); vf[13] = tr_read<v_rd_off(3, 2 * H, 1)>(vb); vf[14] = tr_read<v_rd_off(3, 2 * H + 1, 0)>(vb); vf[15] = tr_read<v_rd_off(3, 2 * H + 1, 1)>(vb);
}
DI void pv_mma(f32x16* o, const s16x4* vf, bf16x8 pa0, bf16x8 pa1) {
#define ATT_PK(L, H_) (bf16x8){L[0], L[1], L[2], L[3], H_[0], H_[1], H_[2], H_[3]}
#pragma unroll
    for (int d0 = 0; d0 < 4; ++d0) {
        o[d0] = __builtin_amdgcn_mfma_f32_32x32x16_bf16(pa0, ATT_PK(vf[4 * d0], vf[4 * d0 + 1]), o[d0], 0, 0, 0);
        o[d0] = __builtin_amdgcn_mfma_f32_32x32x16_bf16(pa1, ATT_PK(vf[4 * d0 + 2], vf[4 * d0 + 3]), o[d0], 0, 0, 0); }
#undef ATT_PK
}
template <int DQK, int D0A, int D0B> DI void k_reads(bf16x8* kf, const LAS unsigned char* Ks, int half, int r32, int hi) {
#pragma unroll
    for (int d0 = D0A; d0 < D0B; ++d0) kf[d0 - D0A] = *(const LAS bf16x8*)(Ks + half * (32 * DQK * 2) + kswz<DQK>(r32, (d0 * 16 + hi * 8) * 2));
}
template <int D0A, int D0B> DI void qk_mma(f32x16& p, const bf16x8* kf, const bf16x8* qr) {
#pragma unroll
    for (int d0 = D0A; d0 < D0B; ++d0) {
        if (d0 == 0) { f32x16 z; _Pragma("unroll") for (int r = 0; r < 16; ++r) z[r] = 0.f; p = __builtin_amdgcn_mfma_f32_32x32x16_bf16(kf[0], qr[0], z, 0, 0, 0); }
        else p = __builtin_amdgcn_mfma_f32_32x32x16_bf16(kf[d0 - D0A], qr[d0], p, 0, 0, 0); }
}

template <int DQK, int MODE, int LDQ, int LDK, int LDV>
DI void attn_body(const bf16_t* __restrict__ Qb, const bf16_t* __restrict__ Kh, const bf16_t* __restrict__ Vh, int q0, float C, const float* __restrict__ gq,
                  float* S0, bf16_t* AOb, float lam, const float* __restrict__ gout, LAS unsigned char* lds, int wv) {
    constexpr int KBUF = 64 * DQK * 2, CPR = DQK / 8, NKP = KBUF / 8192, ND0 = DQK / 16, NT = SEQ / 64;
    int tid_ = fresh_tid<100 + MODE>(wv); const int tid = tid_, wid = __builtin_amdgcn_readfirstlane(tid >> 6), lane = tid & 63, r32 = lane & 31, hi = lane >> 5;
    LAS float* ws = (LAS float*)(lds + WS_OFF) + wid * 64; LAS float* li_l = ws;
    const LAS float* bt = (const LAS float*)(lds + BT_OFF);
    float l_reg = 0.f; f32x16 o[4];
#pragma unroll
    for (int d = 0; d < 4; ++d)
#pragma unroll
        for (int r = 0; r < 16; ++r) o[d][r] = 0.f;
    int kgo[NKP], vgo[2];
#pragma unroll
    for (int i = 0; i < NKP; ++i) { const int L = (wid + 8 * i) * 64 + lane, row = L / CPR, slot = L % CPR, cc = (slot & ~7) | ((slot & 7) ^ ((row >> 1) & 7)); kgo[i] = row * LDK + cc * 8; }
#pragma unroll
    for (int i = 0; i < 2; ++i) { const int L = (2 * wid + i) * 64 + lane, st = L >> 5, w5 = L & 31, kk = (st >> 2) * 8 + (w5 >> 2), c = (st & 3) * 32 + (w5 & 3) * 8;
        const int k = (kk & ~0xC) | ((kk & 4) << 1) | ((kk & 8) >> 1); vgo[i] = k * LDV + c; }
#define ATT_DMA_K(t) do { const bf16_t* kg_ = Kh + (size_t)(t) * 64 * LDK; LAS unsigned char* sb_ = lds + ((t) & 3) * KBUF; \
    _Pragma("unroll") for (int i_ = 0; i_ < NKP; ++i_) __builtin_amdgcn_global_load_lds((const unsigned*)(kg_ + kgo[i_]), (LAS unsigned*)(sb_ + (wid + 8 * i_) * 1024), 16, 0, 0); } while (0)
#define ATT_DMA_V(t, vs) do { const bf16_t* vg_ = Vh + (size_t)(t) * 64 * LDV; LAS unsigned char* sb_ = lds + V_OFF + (vs) * SHM_V; \
    _Pragma("unroll") for (int i_ = 0; i_ < 2; ++i_) __builtin_amdgcn_global_load_lds((const unsigned*)(vg_ + vgo[i_]), (LAS unsigned*)(sb_ + (2 * wid + i_) * 1024), 16, 0, 0); } while (0)
    ATT_DMA_K(0); ATT_DMA_K(1); ATT_DMA_V(0, 0); ATT_DMA_K(2); ATT_DMA_V(1, 1);
    bf16x8 qr[ND0];
    { const bf16_t* Qw = Qb + (size_t)(wid * 32 + r32) * LDQ + hi * 8;
#pragma unroll
      for (int d0 = 0; d0 < ND0; ++d0) qr[d0] = *(const bf16x8*)(Qw + d0 * 16);
      if constexpr (MODE == 0) {
          float ss = 0.f;
#pragma unroll
          for (int d0 = 0; d0 < ND0; ++d0)
#pragma unroll
              for (int j = 0; j < 8; ++j) { const float f = bf2f((unsigned short)qr[d0][j]); ss += f * f; }
          ss = swap_sum(ss);
          const float rstd = rsqrtf(ss * (1.f / DQK) + EPS) * C;
#pragma unroll
          for (int d0 = 0; d0 < ND0; ++d0) { const float* g = gq + d0 * 16 + hi * 8;
              { float f[8]; _Pragma("unroll") for (int j = 0; j < 8; ++j) f[j] = bf2f((unsigned short)qr[d0][j]) * rstd * g[j];
                u32x4 w = {cvtpk(f[0], f[1]), cvtpk(f[2], f[3]), cvtpk(f[4], f[5]), cvtpk(f[6], f[7])}; qr[d0] = __builtin_bit_cast(bf16x8, w); asm volatile("" ::: "memory"); } }
      } }
    const int qlo = q0 + wid * 32, qpos = qlo + r32;
    const int tL = MODE == 0 ? 0 : (qlo >= 191 ? (qlo - 127) >> 6 : 0), tR = MODE == 0 ? NT : min(NT, (qlo + 222) >> 6);
    float fL = 1.f, fR = 1.f; if constexpr (MODE != 0) { fL = __builtin_amdgcn_exp2f(bt[0]); fR = __builtin_amdgcn_exp2f(-bt[448]); }
#define ATT_SEG(t) do { if constexpr (MODE != 0) { if (((t) == tL && tL > 0) || (t) == tR) { const float f_ = (t) == tR ? fR : fL; l_reg *= f_; \
    _Pragma("unroll") for (int d = 0; d < 4; ++d) _Pragma("unroll") for (int r = 0; r < 16; ++r) o[d][r] *= f_; } } } while (0)
#define ATT_BIAS(P, t, half) do { if constexpr (MODE != 0) { if ((t) >= tL && (t) < tR) { const LAS float* bp_ = bt + ((t) * 64 + (half) * 32 - qpos + 224 + 4 * hi);     \
    _Pragma("unroll") for (int r = 0; r < 16; ++r) P[r] += bp_[(r & 3) + 8 * (r >> 2)]; } } } while (0)
    const int vbase = (int)(unsigned)(size_t)lds + V_OFF + v_rd_base(lane);
#define ATT_TOP(N) do { asm volatile("s_waitcnt vmcnt(%0)" :: "n"(N) : "memory"); __builtin_amdgcn_s_barrier(); asm volatile("" ::: "memory"); } while (0)
#define ATT_LGKM0() do { SBAR(); asm volatile("s_waitcnt lgkmcnt(0)" ::: "memory"); SBAR(); } while (0)
    constexpr int NDA = ND0 > 6 ? 6 : ND0;
#define ATT_STEP(PC, PN, H, SV, DO_NEXT, HN, TN) do { bf16x8 kf[NDA]; s16x4 vf[16]; const LAS unsigned char* ks_ = lds + ((TN) & 3) * KBUF; \
        if (DO_NEXT) k_reads<DQK, 0, NDA>(kf, ks_, HN, r32, hi); \
        v_reads<H>(vf, vbase + (SV) * SHM_V); SBAR(); \
        expsum(PC, l_reg, pa0, pa1); SBAR(); ATT_LGKM0(); \
        if constexpr (ND0 > NDA) { bf16x8 kg[ND0 - NDA]; if (DO_NEXT) k_reads<DQK, NDA, ND0>(kg, ks_, HN, r32, hi); SBAR(); \
            pv_mma(o, vf, pa0, pa1); if (DO_NEXT) { qk_mma<0, NDA>(PN, kf, qr); ATT_LGKM0(); qk_mma<NDA, ND0>(PN, kg, qr); } } \
        else { pv_mma(o, vf, pa0, pa1); if (DO_NEXT) qk_mma<0, NDA>(PN, kf, qr); } \
        if (DO_NEXT) ATT_BIAS(PN, TN, HN); SBAR(); } while (0)
    f32x16 pA, pB; bf16x8 pa0, pa1;
    int v0 = 0, v1 = 1, v2 = 2;
    ATT_TOP(NKP + 2);
    { bf16x8 kf[NDA]; k_reads<DQK, 0, NDA>(kf, lds, 0, r32, hi); ATT_LGKM0(); qk_mma<0, NDA>(pA, kf, qr);
      if constexpr (ND0 > NDA) { bf16x8 kg[ND0 - NDA]; k_reads<DQK, NDA, ND0>(kg, lds, 0, r32, hi); ATT_LGKM0(); qk_mma<NDA, ND0>(pA, kg, qr); }
      ATT_BIAS(pA, 0, 0); }
    if (wid >= 4) __builtin_amdgcn_s_setprio(1);
    for (int j = 0; j < NT; ++j) {
        if (j + 2 < NT) ATT_TOP(NKP + 2); else ATT_TOP(0);
        if (j + 3 < NT) ATT_DMA_K(j + 3);
        if (j + 2 < NT) ATT_DMA_V(j + 2, v2);
        ATT_SEG(j); SBAR();
        ATT_STEP(pA, pB, 0, v0, true, 1, j);
        ATT_STEP(pB, pA, 1, v0, (j + 1 < NT), 0, j + 1);
        { const int t_ = v0; v0 = v1; v1 = v2; v2 = t_; }
    }
    __builtin_amdgcn_s_setprio(0);
#undef ATT_STEP
#undef ATT_LGKM0
    l_reg = swap_sum(l_reg);
    { const int lane2 = fresh_tid<110 + MODE>(wv) & 63, r32 = lane2 & 31, hi = lane2 >> 5;
    if (hi == 0) li_l[r32] = l_reg;
    asm volatile("s_waitcnt lgkmcnt(0)" ::: "memory");
    float s0v[MODE == 2 ? 16 : 1][4];
    if constexpr (MODE == 2) {
#pragma unroll
        for (int r = 0; r < 16; ++r)
#pragma unroll
            for (int d0 = 0; d0 < 4; ++d0) s0v[r][d0] = S0[(size_t)(wid * 32 + crow(r, hi)) * 512 + d0 * 32 + r32];
    }
#pragma unroll
    for (int r = 0; r < 16; ++r) { const int orow = wid * 32 + crow(r, hi); const float rl = __builtin_amdgcn_rcpf(li_l[crow(r, hi)]);
        if constexpr (MODE == 0) {
#pragma unroll
            for (int d0 = 0; d0 < 4; ++d0) AOb[(size_t)orow * 1024 + d0 * 32 + r32] = f2bf(o[d0][r] * rl);
        } else if constexpr (MODE == 1) {
#pragma unroll
            for (int d0 = 0; d0 < 4; ++d0) S0[(size_t)orow * 512 + d0 * 32 + r32] = o[d0][r] * rl;
        } else {
            float v[4]; float ss = 0.f;
#pragma unroll
            for (int d0 = 0; d0 < 4; ++d0) { v[d0] = s0v[r][d0] - lam * (o[d0][r] * rl); ss += v[d0] * v[d0]; }
#pragma unroll
            for (int mk = 1; mk <= 16; mk <<= 1) ss += shx(ss, mk, lane2);
            const float rs = rsqrtf(ss * (1.f / 128.f) + EPS) * 0.8f;
#pragma unroll
            for (int d0 = 0; d0 < 4; ++d0) AOb[(size_t)orow * 1024 + d0 * 32 + r32] = f2bf(v[d0] * rs * gout[d0 * 32 + r32]);
        } }
    }
#undef ATT_DMA_K
#undef ATT_DMA_V
#undef ATT_SEG
#undef ATT_BIAS
#undef ATT_TOP
}
}
struct MapIn  { DI int operator()(int n) const {
                    if (n < 384) return n;
                    if (n < 512) { const int u = n - 384; if (u >= 64) return -1; const int wc = u >> 5, fq = (u >> 3) & 3, nn = (u >> 2) & 1, j = u & 3; return 384 + nn * 32 + 16 * wc + 4 * fq + j; }
                    if (n < 1536) { const int t = n & 255, tb = n - t, bj = t >> 7, wc = (t >> 5) & 3, u = t & 31; return tb + 64 * wc + 32 * bj + u - 64; }
                    return n - 64; } };
struct MapUq  { DI int operator()(int n) const { const int h = n / 192, d = n - h * 192; if (d < 128) return n;
                    const int u = d - 128, w = u >> 5, fq = (u >> 3) & 3, nn = (u >> 2) & 1, j = u & 3; return h * 192 + 128 + nn * 32 + 16 * w + 4 * fq + j; } };
struct MapId  { DI int operator()(int n) const { return n; } };
template <class ColMap>
DI void transpose_w(LAS float* tile, const float* __restrict__ w, int Ksrc, int Nsrc, const float* __restrict__ gain, bf16_t* __restrict__ out, int Nout, int Kout, ColMap cm, int gw, int ngw, int lane) {
    const int tilesK = Kout / 64, ntile = tilesK * (Nout / 64);
    for (int t = gw; t < ntile; t += ngw) { const int k0 = (t % tilesK) * 64, n0 = (t / tilesK) * 64; const int scol = cm(n0 + lane);
#pragma unroll
        for (int c = 0; c < 4; ++c) { float v[16];
#pragma unroll
            for (int i = 0; i < 16; ++i) { const int k = k0 + c * 16 + i; v[i] = (scol >= 0 && k < Ksrc) ? w[(size_t)k * Nsrc + scol] * (gain ? gain[k] : 1.f) : 0.f; }
#pragma unroll
            for (int i = 0; i < 16; ++i) tile[(c * 16 + i) * 65 + lane] = v[i]; }
        asm volatile("s_waitcnt lgkmcnt(0)" ::: "memory");
#pragma unroll 8
        for (int nl = 0; nl < 64; ++nl) out[(size_t)(n0 + nl) * Kout + k0 + lane] = f2bf(tile[lane * 65 + nl]);
        asm volatile("s_waitcnt lgkmcnt(0)" ::: "memory"); }
}
DI void phase0(const Params& p, LAS unsigned char* lds, int wv) {
    int tid_ = fresh_tid<1>(wv); const int tid = tid_, bid = blockIdx.x, nb = gridDim.x, wave = tid >> 6, lane = tid & 63;
    unsigned char* ws = p.ws; LAS float* tile = (LAS float*)lds + wave * (64 * 65);
    const int ngw = nb * 8, gw = bid * 8 + wave;
    transpose_w(tile, p.w_up, 1024, 4096, p.mlp_norm_w, (bf16_t*)(ws + WS_WUP), 4096, 1024, MapId(), gw, ngw, lane);
    transpose_w(tile, p.w_down, 4096, 1024, nullptr, (bf16_t*)(ws + WS_WDN), 1024, 4096, MapId(), (gw + ngw / 2) % ngw, ngw, lane);
    transpose_w(tile, p.w_in, 1024, 1984, p.attn_norm_w, (bf16_t*)(ws + WS_WIN), 2048, 1024, MapIn(), (gw + ngw / 4) % ngw, ngw, lane);
    transpose_w(tile, p.w_out, 1024, 1024, nullptr, (bf16_t*)(ws + WS_WOUT), 1024, 1024, MapId(), (gw + 3 * ngw / 4) % ngw, ngw, lane);
    transpose_w(tile, p.w_uq, 256, 768, p.q_a_norm_w, (bf16_t*)(ws + WS_WUQ), 768, 256, MapUq(), (gw + 7 * ngw / 8) % ngw, ngw, lane);
    transpose_w(tile, p.w_ukv, 128, 1024, p.kv_a_norm_w, (bf16_t*)(ws + WS_WUKV), 1024, 128, MapId(), (gw + 15 * ngw / 16) % ngw, ngw, lane);
    bf16_t* xb = (bf16_t*)(ws + WS_XB); float* rstd1 = (float*)(ws + WS_RSTD1);
    for (int row0 = (bid * 8 + wave) * 4; row0 < M_TOK; row0 += nb * 32) { f32x4 v[4][4]; float ss[4] = {0.f, 0.f, 0.f, 0.f};
#pragma unroll
        for (int q = 0; q < 4; ++q) { const f32x4* xr = (const f32x4*)(p.x + (size_t)(row0 + q) * 1024);
#pragma unroll
            for (int i = 0; i < 2; ++i) { v[q][2 * i] = __builtin_nontemporal_load(xr + 2 * lane + 128 * i); v[q][2 * i + 1] = __builtin_nontemporal_load(xr + 2 * lane + 1 + 128 * i); } }
#pragma unroll
        for (int q = 0; q < 4; ++q) {
#pragma unroll
            for (int i = 0; i < 4; ++i) ss[q] += (v[q][i][0] * v[q][i][0] + v[q][i][1] * v[q][i][1]) + (v[q][i][2] * v[q][i][2] + v[q][i][3] * v[q][i][3]);
#pragma unroll
            for (int i = 0; i < 2; ++i) { u32x4 w; w.x = cvt_pk_bf16(v[q][2 * i][0], v[q][2 * i][1]); w.y = cvt_pk_bf16(v[q][2 * i][2], v[q][2 * i][3]);
                w.z = cvt_pk_bf16(v[q][2 * i + 1][0], v[q][2 * i + 1][1]); w.w = cvt_pk_bf16(v[q][2 * i + 1][2], v[q][2 * i + 1][3]);
                *(u32x4*)(xb + (size_t)(row0 + q) * 1024 + (2 * lane + 128 * i) * 4) = w; } }
#pragma unroll
        for (int q = 0; q < 4; ++q) ss[q] = wave_sum(ss[q], lane);
        if (lane < 4) rstd1[row0 + lane] = rsqrtf((lane == 0 ? ss[0] : lane == 1 ? ss[1] : lane == 2 ? ss[2] : ss[3]) * (1.f / 1024.f) + EPS); }
    { float* ssum2 = (float*)(ws + WS_SSUM2); for (int i = bid * 512 + tid; i < M_TOK; i += nb * 512) ssum2[i] = 0.f; }
    float* cs = (float*)(ws + WS_ROPE); float* sn = cs + SEQ * 32;
    for (int idx = bid * 512 + tid; idx < SEQ * 32; idx += nb * 512) { const int pos = idx >> 5, i = idx & 31;
        const float inv = exp2f(-(float)i * (13.287712379549449f / 32.f)); const float ang = (float)pos * inv;
        const double rev = (double)ang * 0.15915494309189535; const float fr = (float)(rev - rint(rev));
        cs[idx] = __builtin_amdgcn_cosf(fr); sn[idx] = __builtin_amdgcn_sinf(fr); }
    if (bid == 0 && wave == 0) { const float d1 = wave_sum(p.lambda_q1[lane] * p.lambda_k1[lane], lane), d2 = wave_sum(p.lambda_q2[lane] * p.lambda_k2[lane], lane);
        if (lane == 0) ((float*)(ws + WS_MISC))[0] = expf(d1) - expf(d2) + 0.2f; }
}
DI void phase2(const Params& p, int wv) {
    int tid_ = fresh_tid<2>(wv); const int tid = tid_, bid = blockIdx.x, nb = gridDim.x, wave = tid >> 6, lane = tid & 63;
    unsigned char* ws = p.ws; bf16_t* P = (bf16_t*)(ws + WS_P); float* KR = (float*)(ws + WS_KR); float* rq = (float*)(ws + WS_RSTDQ); float* rkv = (float*)(ws + WS_RSTDKV); float* sskr_o = (float*)(ws + WS_SSKR);
    const float* cs = (const float*)(ws + WS_ROPE); const float* sn = cs + SEQ * 32;
    float gdq[8], gdk[8];
#pragma unroll
    for (int j = 0; j < 8; ++j) { gdq[j] = p.diff_q_norm_w[(lane & 7) * 8 + j] * (0.125f * LOG2E); gdk[j] = p.diff_k_norm_w[(lane & 7) * 8 + j]; }
    const int stride = nb * 8; int row = bid * 8 + wave;
    u32x2 cq_n; unsigned ckv_n; unsigned short kr_n; u32x4 dq_n, dk_n;
#define P2_LOAD(R) do { const bf16_t* pl_ = P + (size_t)(R) * 2048; cq_n = *(const u32x2*)(pl_ + lane * 4); ckv_n = *(const unsigned*)(pl_ + 256 + lane * 2); kr_n = pl_[384 + lane]; \
        dq_n = *(const u32x4*)(pl_ + 512 + lane * 8); dk_n = *(const u32x4*)(pl_ + 1024 + lane * 8); } while (0)
    if (row < M_TOK) P2_LOAD(row);
    for (; row < M_TOK; row += stride) { bf16_t* pr = P + (size_t)row * 2048;
        const u32x2 cq = cq_n; const unsigned ckv = ckv_n; const float kr = bf2f(kr_n); const u32x4 dq = dq_n, dk = dk_n;
        if (row + stride < M_TOK) P2_LOAD(row + stride);
        float a0 = __uint_as_float(cq.x << 16), a1 = __uint_as_float(cq.x & 0xffff0000u), a2 = __uint_as_float(cq.y << 16), a3 = __uint_as_float(cq.y & 0xffff0000u);
        float ssq = (a0 * a0 + a1 * a1) + (a2 * a2 + a3 * a3);
        float b0 = __uint_as_float(ckv << 16), b1 = __uint_as_float(ckv & 0xffff0000u); float sskv = b0 * b0 + b1 * b1;
        ssq = wave_sum(ssq, lane); sskv = wave_sum(sskv, lane); const float sskr = wave_sum(kr * kr, lane);
        const float partner = shx(kr, 32, lane); const int pos = row & (SEQ - 1), i = lane & 31; const float c = cs[pos * 32 + i], s = sn[pos * 32 + i];
        KR[(size_t)row * 64 + lane] = lane < 32 ? kr * c - partner * s : kr * c + partner * s;
        float fq_[8], fk_[8]; float sq = 0.f, sk = 0.f;
#pragma unroll
        for (int j = 0; j < 4; ++j) { fq_[2 * j] = __uint_as_float(dq[j] << 16); fq_[2 * j + 1] = __uint_as_float(dq[j] & 0xffff0000u); fk_[2 * j] = __uint_as_float(dk[j] << 16); fk_[2 * j + 1] = __uint_as_float(dk[j] & 0xffff0000u); }
#pragma unroll
        for (int j = 0; j < 8; ++j) { sq += fq_[j] * fq_[j]; sk += fk_[j] * fk_[j]; }
#pragma unroll
        for (int mk = 1; mk <= 4; mk <<= 1) { sq += shx(sq, mk, lane); sk += shx(sk, mk, lane); }
        const float rsq = rsqrtf(sq * (1.f / 64.f) + EPS), rsk = rsqrtf(sk * (1.f / 64.f) + EPS);
        u32x4 oq, ok;
#pragma unroll
        for (int j = 0; j < 4; ++j) { oq[j] = cvt_pk_bf16(fq_[2 * j] * rsq * gdq[2 * j], fq_[2 * j + 1] * rsq * gdq[2 * j + 1]); ok[j] = cvt_pk_bf16(fk_[2 * j] * rsk * gdk[2 * j], fk_[2 * j + 1] * rsk * gdk[2 * j + 1]); }
        *(u32x4*)(pr + 512 + lane * 8) = oq; *(u32x4*)(pr + 1024 + lane * 8) = ok;
        if (lane == 0) { rq[row] = rsqrtf(ssq * (1.f / 256.f) + EPS); rkv[row] = rsqrtf(sskv * (1.f / 128.f) + EPS); sskr_o[row] = sskr; } }
}
DI void phase3b(const Params& p, int wv) {
    int tid_ = fresh_tid<3>(wv); const int tid = tid_, bid = blockIdx.x, nb = gridDim.x, wave = tid >> 6, lane = tid & 63;
    unsigned char* ws = p.ws; bf16_t* KM = (bf16_t*)(ws + WS_KM); const float* KR = (const float*)(ws + WS_KR);
    const int hh = lane >> 4, d8 = (lane & 15) * 8; float g[8];
#pragma unroll
    for (int j = 0; j < 8; ++j) g[j] = p.mla_k_norm_w[d8 + j];
    const float gr = p.mla_k_norm_w[128 + lane];
    const int stride = nb * 8; int row = bid * 8 + wave; u32x4 kn_n; float r_n;
#define P3B_LOAD(R) do { kn_n = *(const u32x4*)(KM + (size_t)(R) * 768 + hh * 192 + d8); r_n = KR[(size_t)(R) * 64 + lane]; } while (0)
    if (row < M_TOK) P3B_LOAD(row);
    for (; row < M_TOK; row += stride) { bf16_t* kr_ = KM + (size_t)row * 768;
        const u32x4 kn = kn_n; const float r = r_n;
        if (row + stride < M_TOK) P3B_LOAD(row + stride);
        float f[8]; float ssn = 0.f;
#pragma unroll
        for (int j = 0; j < 4; ++j) { f[2 * j] = __uint_as_float(kn[j] << 16); f[2 * j + 1] = __uint_as_float(kn[j] & 0xffff0000u); }
#pragma unroll
        for (int j = 0; j < 8; ++j) ssn += f[j] * f[j];
#pragma unroll
        for (int mk = 1; mk <= 8; mk <<= 1) ssn += shx(ssn, mk, lane);
        const float ssr = wave_sum(r * r, lane);
        const float rstd = rsqrtf((ssn + ssr) * (1.f / 192.f) + EPS);
        u32x4 w;
#pragma unroll
        for (int j = 0; j < 4; ++j) w[j] = cvt_pk_bf16(f[2 * j] * rstd * g[2 * j], f[2 * j + 1] * rstd * g[2 * j + 1]);
        *(u32x4*)(kr_ + hh * 192 + d8) = w;
#pragma unroll
        for (int h2 = 0; h2 < 4; ++h2) { const float rh = shl_from(rstd, h2 * 16); kr_[h2 * 192 + 128 + lane] = f2bf(r * rh * gr); } }
}
DI void phase4(const Params& p, LAS unsigned char* lds, int wv) {
    unsigned char* ws = p.ws;
    const bf16_t* P = (const bf16_t*)(ws + WS_P); const bf16_t* Q = (const bf16_t*)(ws + WS_Q); const bf16_t* KM = (const bf16_t*)(ws + WS_KM); const bf16_t* V = (const bf16_t*)(ws + WS_V);
    bf16_t* AO = (bf16_t*)(ws + WS_AO); float* S0 = (float*)(ws + WS_S0); const float lam = ((const float*)(ws + WS_MISC))[0];
    for (int L = blockIdx.x; L < 2048; L += gridDim.x) {
        const int i = L >> 8, c = L & 255, x = c & 7, j = c >> 3, g = i * 8 + x, b = g >> 2, h = g & 3, kind = ((j >> 4) + i) & 1, qb = j & 15;
        const size_t rowbase = (size_t)b * SEQ, qrow = rowbase + qb * 256;
        if (kind == 0) {
            att::attn_body<192, 0, 768, 768, 512>(Q + qrow * 768 + h * 192, KM + rowbase * 768 + h * 192, V + rowbase * 512 + h * 128, qb * 256, 0.07216878364870322f * LOG2E,
                                                 p.mla_q_norm_w, nullptr, AO + qrow * 1024 + h * 128, 0.f, nullptr, lds, wv);
            __syncthreads();
        } else {
            LAS float* bt = (LAS float*)(lds + att::BT_OFF);
            const int tid = fresh_tid<4>(wv);
            if (tid < 449) { const int rel = tid - 224, n = rel < 0 ? -rel : rel;
                int lg = 8 + (n >= 12) + (n >= 16) + (n >= 23) + (n >= 32) + (n >= 46) + (n >= 64) + (n >= 91); const int bucket = (rel > 0 ? 16 : 0) + (n < 8 ? n : lg);
                bt[tid] = p.rel_bias[bucket * 4 + h] * LOG2E; }
            __syncthreads();
            att::attn_body<64, 1, 2048, 2048, 2048>(P + qrow * 2048 + 512 + h * 128, P + rowbase * 2048 + 1024 + h * 128, P + rowbase * 2048 + 1536 + h * 128, qb * 256, 0.f,
                                                   nullptr, S0 + qrow * 512 + h * 128, nullptr, 0.f, nullptr, lds, wv);
            __syncthreads();
            att::attn_body<64, 2, 2048, 2048, 2048>(P + qrow * 2048 + 512 + h * 128 + 64, P + rowbase * 2048 + 1024 + h * 128 + 64, P + rowbase * 2048 + 1536 + h * 128, qb * 256, 0.f,
                                                   nullptr, S0 + qrow * 512 + h * 128, AO + qrow * 1024 + 512 + h * 128, lam, p.diff_out_norm_w, lds, wv);
            __syncthreads();
        }
    }
}

constexpr int LDS_BYTES = 148 * 1024;
static_assert(att::ATT_LDS <= LDS_BYTES && pg8::STAGE_BYTES <= LDS_BYTES, "LDS must fit");
template <class Epi> DI void run_gemm(LAS unsigned char* lds, int wv, const bf16_t* A, int lda, const bf16_t* Bt, int N, int K, const Epi& E) {
    if (K <= 256) asm volatile("" : "+s"(K), "+s"(N), "+s"(lda));
    pg8::Gemm g{A, Bt, M_TOK, N, K, lda}; pg8::StaticOrder S; S.init(M_TOK, N, (int)gridDim.x, (int)blockIdx.x);
    pg8::gemm_phase<Epi, pg8::StaticOrder, true, true>(lds, g, S, E, wv);
}
template <int TAG> DI void fast_grid_sync(unsigned* cnt, int wv) {
    __syncthreads();
    if (wv == 0) {
        __builtin_amdgcn_fence(__ATOMIC_RELEASE, "agent");
        if ((fresh_tid<200 + TAG>(wv) & 63) == 0) {
            const unsigned G = gridDim.x, g = blockIdx.x & 7u, members = (G - g + 7u) >> 3, ngroups = G < 8u ? G : 8u;
            if (__hip_atomic_fetch_add(cnt + g * 32, 1u, __ATOMIC_RELAXED, __HIP_MEMORY_SCOPE_AGENT) == members - 1u)
                __hip_atomic_fetch_add(cnt + 8 * 32, 1u, __ATOMIC_RELAXED, __HIP_MEMORY_SCOPE_AGENT);
            while (__hip_atomic_load(cnt + 8 * 32, __ATOMIC_RELAXED, __HIP_MEMORY_SCOPE_AGENT) < ngroups) __builtin_amdgcn_s_sleep(1);
        }
        __builtin_amdgcn_fence(__ATOMIC_ACQUIRE, "agent");
    }
    __syncthreads();
}
__global__ void __launch_bounds__(512) fwd_kernel(Params p) {
    extern __shared__ __attribute__((aligned(16))) unsigned char lds_raw[];
    LAS unsigned char* lds = (LAS unsigned char*)lds_raw;
    cg::grid_group grid = cg::this_grid();
    const int wv = __builtin_amdgcn_readfirstlane(threadIdx.x >> 6);
    unsigned char* ws = p.ws; unsigned* bar = (unsigned*)(ws + WS_BAR);
    bf16_t* XB = (bf16_t*)(ws + WS_XB); bf16_t* P = (bf16_t*)(ws + WS_P); bf16_t* Q = (bf16_t*)(ws + WS_Q); bf16_t* KM = (bf16_t*)(ws + WS_KM); bf16_t* V = (bf16_t*)(ws + WS_V);
    bf16_t* U = (bf16_t*)(ws + WS_U); bf16_t* AO = (bf16_t*)(ws + WS_AO);
    float* ssq2 = (float*)(ws + WS_SSQ2); const float* cs = (const float*)(ws + WS_ROPE);
    phase0(p, lds, wv);
    fast_grid_sync<1>(bar + 2560, wv);
    if (p.ws == nullptr) grid.sync();
    { EpiProj E{P, (const float*)(ws + WS_RSTD1), (float*)(ws + WS_SSQ4), (float*)(ws + WS_SSKV4), (float*)(ws + WS_SSKR2), (float*)(ws + WS_KR), cs, cs + SEQ * 32, p.diff_q_norm_w, p.diff_k_norm_w}; run_gemm(lds, wv, XB, 1024, (const bf16_t*)(ws + WS_WIN), 2048, 1024, E); }
    fast_grid_sync<2>(bar + 0, wv);
    { EpiQ E{Q, (const float*)(ws + WS_SSQ4), cs, cs + SEQ * 32}; run_gemm(lds, wv, P, 2048, (const bf16_t*)(ws + WS_WUQ), 768, 256, E); }
    { EpiKV E{KM, V, (const float*)(ws + WS_SSKV4), (const float*)(ws + WS_KR), (const float*)(ws + WS_SSKR2), p.mla_k_norm_w, (LAS float*)(lds + pg8::STAGE_BYTES)}; run_gemm(lds, wv, P + 256, 2048, (const bf16_t*)(ws + WS_WUKV), 1024, 128, E); }
    fast_grid_sync<3>(bar + 512, wv);
    phase4(p, lds, wv);
    fast_grid_sync<4>(bar + 1024, wv);
    { EpiOut E{XB, (float*)(ws + WS_SSUM2)}; run_gemm(lds, wv, AO, 1024, (const bf16_t*)(ws + WS_WOUT), 1024, 1024, E); }
    fast_grid_sync<5>(bar + 1536, wv);
    { EpiUp E{U, (const float*)(ws + WS_SSUM2)}; run_gemm(lds, wv, XB, 1024, (const bf16_t*)(ws + WS_WUP), 4096, 1024, E); }
    fast_grid_sync<6>(bar + 2048, wv);
    { EpiDown E{p.out, XB}; run_gemm(lds, wv, U, 4096, (const bf16_t*)(ws + WS_WDN), 1024, 4096, E); }
}

extern "C" void kernel_launch(void* const* d_in, const int* in_sizes, int n_in, void* d_out, int out_size, void* d_ws, size_t ws_size, hipStream_t stream) {
    static int grid_blocks = 0;
    if (grid_blocks == 0) {
        if (n_in != 21 || in_sizes[0] != M_TOK * 1024 || out_size != M_TOK * 1024 || ws_size < WS_END) { fprintf(stderr, "kernel_launch: unexpected shapes (n_in %d, in0 %d, out %d, ws %zu)\n", n_in, n_in > 0 ? in_sizes[0] : -1, out_size, ws_size); grid_blocks = -1; return; }
        int dev = 0, cus = 0, per_cu = 0;
        hipGetDevice(&dev); hipDeviceGetAttribute(&cus, hipDeviceAttributeMultiprocessorCount, dev);
        if (hipFuncSetAttribute((const void*)fwd_kernel, hipFuncAttributeMaxDynamicSharedMemorySize, LDS_BYTES) != hipSuccess) { fprintf(stderr, "kernel_launch: hipFuncSetAttribute failed\n"); grid_blocks = -1; return; }
        if (hipOccupancyMaxActiveBlocksPerMultiprocessor(&per_cu, (const void*)fwd_kernel, 512, LDS_BYTES) != hipSuccess || per_cu < 1) { fprintf(stderr, "kernel_launch: occupancy query says %d\n", per_cu); per_cu = 1; }
        (void)hipGetLastError();
        grid_blocks = cus * 1;
    }
    if (grid_blocks < 0) return;
    Params p{};
    const float** pp = (const float**)&p;
    for (int i = 0; i < 21; ++i) pp[i] = (const float*)d_in[i];
    p.out = (float*)d_out; p.ws = (unsigned char*)d_ws;
    if (hipMemsetAsync((unsigned char*)d_ws + WS_BAR, 0, 16384, stream) != hipSuccess) { fprintf(stderr, "kernel_launch: hipMemsetAsync failed\n"); return; }
    void* args[] = {&p};
    hipError_t e = hipLaunchCooperativeKernel((const void*)fwd_kernel, dim3(grid_blocks), dim3(512), args, LDS_BYTES, stream);
    if (e != hipSuccess) fprintf(stderr, "cooperative launch failed: %s (grid %d)\n", hipGetErrorString(e), grid_blocks);
}
```

```cpp
#include <hip/hip_runtime.h>
#include <hip/hip_bf16.h>
#include <hip/hip_cooperative_groups.h>
#include <cstdio>
#include <cstdint>
namespace cg = cooperative_groups;
#define DI __device__ __forceinline__
#define LAS __attribute__((address_space(3)))
template <int TAG = 0> DI int fresh_tid(int wv) { int l; asm volatile("v_mbcnt_lo_u32_b32 %0, -1, 0\n\tv_mbcnt_hi_u32_b32 %0, -1, %0 ; site %1" : "=v"(l) : "n"(TAG)); return wv * 64 + l; }
namespace pg8 {
#define PG8_LAS __attribute__((address_space(3)))
typedef unsigned short bf16_t;
typedef short bf16x8 __attribute__((ext_vector_type(8)));
typedef float f32x4 __attribute__((ext_vector_type(4)));
typedef unsigned u32x4 __attribute__((ext_vector_type(4)));
constexpr int BM = 256, BK = 64, HALF = 128, HTB = HALF * BK * 2  , STAGE_BYTES = 8 * HTB, NXCD = 8, WGM = 8;

__host__ __device__ __forceinline__ int lds_byte(int r, int c) { const int st = (r >> 4) * 2 + (c >> 5), rr = r & 15, cc = c & 31, ob = rr * 64 + cc * 2; return st * 1024 + (ob ^ (((ob >> 9) & 1) << 5)); }
__host__ __device__ __forceinline__ void stage_rc(int b, int& R, int& C) { const int st = b / 1024, sb = b % 1024, swz = sb ^ (((sb >> 9) & 1) << 5); R = (st >> 1) * 16 + swz / 64; C = (st & 1) * 32 + (swz % 64) / 2; }
__host__ __device__ __forceinline__ int perm32(int rho) { const int n = rho >> 4, i = rho & 15; return 8 * (i >> 2) + 4 * n + (i & 3); }

struct Unit { int pm, pn; };
struct Gemm { const bf16_t* A; const bf16_t* Bt; int M, N, K, lda; };

struct StaticOrder {
    int nM, nN, nwg, G, c;
    __host__ __device__ void init(int M, int N, int G_, int c_) { nM = M / BM; nN = N / BM; nwg = nM * nN; G = G_; c = c_; }
    __host__ __device__ bool next(int i, Unit& u) const {
        const long L = (long)i * G + c; if (L >= nwg) return false;
        int wgid = (int)L; { const int q = nwg / NXCD, r = nwg % NXCD, xcd = wgid % NXCD, off = wgid / NXCD; wgid = (xcd < r ? xcd * (q + 1) : r * (q + 1) + (xcd - r) * q) + off; }
        const int nig = WGM * nN, gid = wgid / nig, fm = gid * WGM, gsz = (nM - fm) < WGM ? (nM - fm) : WGM;
        u.pm = fm + ((wgid % nig) % gsz); u.pn = (wgid % nig) / gsz; return true;
    }
    __device__ __forceinline__ void a_ready(const Unit&) const {}
    __device__ __forceinline__ void done(const Unit&) const {}
};

__device__ __forceinline__ unsigned cvt_pk_bf16(float lo, float hi) { unsigned r; asm volatile("v_cvt_pk_bf16_f32 %0, %1, %2" : "=v"(r) : "v"(lo), "v"(hi)); return r; }
typedef float f32x2 __attribute__((ext_vector_type(2)));
template <class Epi, class Sched, bool ALIGN_EPI = false, bool SP2 = false>
__device__ __forceinline__ void gemm_phase(PG8_LAS unsigned char* lds, const Gemm g, const Sched& S, const Epi& E, int wv) {
    int tid_ = fresh_tid<50>(wv); const int tid = tid_, wid = __builtin_amdgcn_readfirstlane(tid >> 6), lane = tid & 63, wr = wid >> 2, wc = wid & 3, fr = lane & 15, fq = lane >> 4;
    const int K = g.K, nt = K / BK;
    unsigned voffA[2], voffB[2];
#pragma unroll
    for (int i = 0; i < 2; ++i) { int R, C; stage_rc(tid * 16 + i * 8192, R, C); const int Rb = Epi::PERM ? ((R & ~31) + perm32(R & 31)) : R;
        voffA[i] = (unsigned)(R * g.lda + C) * 2u; voffB[i] = (unsigned)(Rb * K + C) * 2u; }
    const size_t kstep = (size_t)(BK * 2);
    const size_t hstepA = (size_t)HALF * g.lda * 2, hstepB = (size_t)HALF * K * 2;
    const size_t tstepA = 2 * hstepA, tstepB = 2 * hstepB;
    const unsigned ldsw = (unsigned)wid * 1024u;
    const int aoff = lds_byte(wr * 64 + fr, fq * 8), boff = lds_byte(wc * 32 + fr, fq * 8);
#define PG8_SA(b, h) (((b) * 2 + (h)) * HTB)
#define PG8_SB(b, h) ((4 + (b) * 2 + (h)) * HTB)
#define PG8_STAGE(bufoff, gbase, voff) do { _Pragma("unroll") for (int _i = 0; _i < 2; ++_i) \
        __builtin_amdgcn_global_load_lds((const unsigned*)((const char*)(gbase) + (voff)[_i]), (PG8_LAS unsigned*)(lds + (bufoff) + ldsw + _i * 8192), 16, 0, 0); } while (0)
#define PG8_LDA(dst, b, h) do { _Pragma("unroll") for (int m = 0; m < 4; ++m) _Pragma("unroll") for (int k = 0; k < 2; ++k) dst[m][k] = *(const PG8_LAS bf16x8*)(lds + PG8_SA(b, h) + aoff + m * 2048 + k * 1024); } while (0)
#define PG8_LDB(dst, b, h) do { _Pragma("unroll") for (int n = 0; n < 2; ++n) _Pragma("unroll") for (int k = 0; k < 2; ++k) dst[n][k] = *(const PG8_LAS bf16x8*)(lds + PG8_SB(b, h) + boff + n * 2048 + k * 1024); } while (0)
#define PG8_MMA(ai, bj, At, Bt) do { __builtin_amdgcn_s_setprio(1); _Pragma("unroll") for (int m = 0; m < 4; ++m) _Pragma("unroll") for (int n = 0; n < 2; ++n) _Pragma("unroll") for (int k = 0; k < 2; ++k) \
        acc[ai][bj][m][n] = __builtin_amdgcn_mfma_f32_16x16x32_bf16(Bt[n][k], At[m][k], acc[ai][bj][m][n], 0, 0, 0); __builtin_amdgcn_s_setprio(0); } while (0)
#define PG8_WAIT_V(n) asm volatile("s_waitcnt vmcnt(" #n ")" ::: "memory")
#define PG8_WAIT_L(n) asm volatile("s_waitcnt lgkmcnt(" #n ")" ::: "memory")
#define PG8_BAR __builtin_amdgcn_s_barrier()
#define PG8_SCHED __builtin_amdgcn_sched_barrier(0)
    Unit cur, nxt; int ui = 0;
    if (!S.next(0, cur)) return;
    f32x4 acc[2][2][4][2];
#pragma unroll
    for (int a = 0; a < 2; ++a)
#pragma unroll
        for (int b = 0; b < 2; ++b)
#pragma unroll
            for (int m = 0; m < 4; ++m)
#pragma unroll
                for (int n = 0; n < 2; ++n) acc[a][b][m][n] = (f32x4){0.f, 0.f, 0.f, 0.f};
    bf16x8 At[4][2], B0[2][2], B1[2][2];
    const char* cA = (const char*)g.A + (size_t)cur.pm * tstepA; const char* cB = (const char*)g.Bt + (size_t)cur.pn * tstepB;
    S.a_ready(cur);
    if constexpr (SP2) {
        PG8_STAGE(PG8_SB(0, 0), cB, voffB); PG8_STAGE(PG8_SB(0, 1), cB + hstepB, voffB); PG8_STAGE(PG8_SA(0, 0), cA, voffA); PG8_STAGE(PG8_SA(0, 1), cA + hstepA, voffA);
        if (wr == 1) PG8_BAR;
        PG8_WAIT_V(2); PG8_BAR;
        PG8_STAGE(PG8_SB(1, 0), cB + kstep, voffB); PG8_STAGE(PG8_SA(1, 0), cA + kstep, voffA); PG8_STAGE(PG8_SB(1, 1), cB + hstepB + kstep, voffB);
        PG8_WAIT_V(6); PG8_BAR;
    } else {
        PG8_STAGE(PG8_SB(0, 0), cB, voffB); PG8_STAGE(PG8_SA(0, 0), cA, voffA); PG8_STAGE(PG8_SB(0, 1), cB + hstepB, voffB); PG8_STAGE(PG8_SA(0, 1), cA + hstepA, voffA);
        if (wr == 1) PG8_BAR;
        PG8_WAIT_V(4); PG8_BAR;
        PG8_STAGE(PG8_SB(1, 0), cB + kstep, voffB); PG8_STAGE(PG8_SA(1, 0), cA + kstep, voffA); PG8_STAGE(PG8_SB(1, 1), cB + hstepB + kstep, voffB);
        PG8_WAIT_V(6); PG8_BAR;
    }
    for (;;) {
        const bool has_next = S.next(ui + 1, nxt);
        const char* nA = has_next ? (const char*)g.A + (size_t)nxt.pm * tstepA : cA; const char* nB = has_next ? (const char*)g.Bt + (size_t)nxt.pn * tstepB : cB;
        for (int t = 0; t < nt; t += 2) {
            const bool last = (t == nt - 2);
            const char* a1 = cA + (size_t)(t + 1) * kstep;
            const char* a2 = last ? nA : cA + (size_t)(t + 2) * kstep; const char* b2 = last ? nB : cB + (size_t)(t + 2) * kstep;
            const char* a3 = a2 + kstep; const char* b3 = b2 + kstep;
            if (last && has_next) S.a_ready(nxt);
            if constexpr (SP2) {
            PG8_LDB(B0, 0, 0); PG8_LDB(B1, 0, 1); PG8_SCHED; PG8_LDA(At, 0, 0); PG8_STAGE(PG8_SA(1, 1), a1 + hstepA, voffA);
            PG8_WAIT_V(8); PG8_WAIT_L(0); PG8_BAR; PG8_MMA(0, 0, At, B0); PG8_MMA(0, 1, At, B1); PG8_BAR; PG8_SCHED;
            PG8_LDA(At, 0, 1); PG8_STAGE(PG8_SB(0, 0), b2, voffB); PG8_STAGE(PG8_SB(0, 1), b2 + hstepB, voffB); PG8_STAGE(PG8_SA(0, 0), a2, voffA);
            PG8_WAIT_V(8); PG8_WAIT_L(0); PG8_BAR; PG8_MMA(1, 0, At, B0); PG8_MMA(1, 1, At, B1); PG8_BAR; PG8_SCHED;
            PG8_LDB(B0, 1, 0); PG8_LDB(B1, 1, 1); PG8_SCHED; PG8_LDA(At, 1, 0); PG8_STAGE(PG8_SA(0, 1), a2 + hstepA, voffA);
            PG8_WAIT_V(8); PG8_WAIT_L(0); PG8_BAR; PG8_MMA(0, 0, At, B0); PG8_MMA(0, 1, At, B1); PG8_BAR; PG8_SCHED;
            PG8_LDA(At, 1, 1); PG8_STAGE(PG8_SB(1, 0), b3, voffB); PG8_STAGE(PG8_SB(1, 1), b3 + hstepB, voffB); PG8_STAGE(PG8_SA(1, 0), a3, voffA);
            PG8_WAIT_V(8); PG8_WAIT_L(0); PG8_BAR; PG8_MMA(1, 0, At, B0); PG8_MMA(1, 1, At, B1); PG8_BAR; PG8_SCHED;
            } else {
            PG8_LDB(B0, 0, 0); PG8_SCHED; PG8_LDA(At, 0, 0); PG8_STAGE(PG8_SA(1, 1), a1 + hstepA, voffA);
            PG8_WAIT_L(8); PG8_BAR; PG8_WAIT_L(0); PG8_MMA(0, 0, At, B0); PG8_BAR; PG8_SCHED;
            PG8_LDB(B1, 0, 1); PG8_STAGE(PG8_SB(0, 0), b2, voffB);
            PG8_BAR; PG8_WAIT_L(0); PG8_MMA(0, 1, At, B1); PG8_BAR;
            PG8_LDA(At, 0, 1); PG8_STAGE(PG8_SA(0, 0), a2, voffA);
            PG8_BAR; PG8_WAIT_L(0); PG8_MMA(1, 0, At, B0); PG8_BAR; PG8_SCHED;
            PG8_STAGE(PG8_SB(0, 1), b2 + hstepB, voffB);
            PG8_WAIT_V(6); PG8_BAR; PG8_MMA(1, 1, At, B1); PG8_BAR;
            PG8_LDB(B0, 1, 0); PG8_SCHED; PG8_LDA(At, 1, 0); PG8_STAGE(PG8_SA(0, 1), a2 + hstepA, voffA);
            PG8_WAIT_L(8); PG8_BAR; PG8_WAIT_L(0); PG8_MMA(0, 0, At, B0); PG8_BAR; PG8_SCHED;
            PG8_LDB(B1, 1, 1); PG8_STAGE(PG8_SB(1, 0), b3, voffB);
            PG8_BAR; PG8_WAIT_L(0); PG8_MMA(0, 1, At, B1); PG8_BAR;
            PG8_LDA(At, 1, 1); PG8_STAGE(PG8_SA(1, 0), a3, voffA);
            PG8_BAR; PG8_WAIT_L(0); PG8_MMA(1, 0, At, B0); PG8_BAR; PG8_SCHED;
            PG8_STAGE(PG8_SB(1, 1), b3 + hstepB, voffB);
            PG8_WAIT_V(6); PG8_BAR; PG8_MMA(1, 1, At, B1); PG8_BAR;
            }
        }
        if constexpr (ALIGN_EPI) { if (wr == 0) PG8_BAR; }
        if constexpr (!Epi::AFTER_DRAIN) { E(acc, cur, wr, wc, fr, fq); S.done(cur); }
        if (!has_next) break;
#pragma unroll
        for (int a = 0; a < 2; ++a)
#pragma unroll
            for (int b = 0; b < 2; ++b)
#pragma unroll
                for (int m = 0; m < 4; ++m)
#pragma unroll
                    for (int n = 0; n < 2; ++n) acc[a][b][m][n] = (f32x4){0.f, 0.f, 0.f, 0.f};
        cur = nxt; cA = nA; cB = nB; ++ui;
        if constexpr (ALIGN_EPI) { if (wr == 1) PG8_BAR; }
    }
    PG8_WAIT_V(0);
    if constexpr (!ALIGN_EPI) { if (wr == 0) PG8_BAR; }
    PG8_BAR;
    if constexpr (Epi::AFTER_DRAIN) { E.fused(acc, cur, wr, wc, fr, fq, lds, wid, lane); S.done(cur); }
#undef PG8_SA
#undef PG8_SB
#undef PG8_STAGE
#undef PG8_LDA
#undef PG8_LDB
#undef PG8_MMA
#undef PG8_WAIT_V
#undef PG8_WAIT_L
#undef PG8_BAR
#undef PG8_SCHED
}
}
using pg8::bf16_t; using pg8::f32x4; using pg8::u32x4; using pg8::Unit; using pg8::cvt_pk_bf16;
typedef unsigned u32x2 __attribute__((ext_vector_type(2)));
constexpr int M_TOK = 65536, SEQ = 4096;
constexpr float EPS = 1e-6f, LOG2E = 1.4426950408889634f;
constexpr size_t MiB = 1ull << 20;
constexpr size_t WS_XB = 0, WS_P = 128 * MiB, WS_Q = 384 * MiB, WS_KM = 480 * MiB, WS_V = 576 * MiB, WS_U = 128 * MiB, WS_AO = 640 * MiB, WS_KR = 768 * MiB,
                 WS_WIN = 784 * MiB, WS_WUQ = 788 * MiB, WS_WUKV = 789 * MiB, WS_WOUT = 790 * MiB, WS_WUP = 792 * MiB, WS_WDN = 800 * MiB,
                 WS_RSTD1 = 808 * MiB, WS_RSTDQ = WS_RSTD1 + 256 * 1024, WS_RSTDKV = WS_RSTDQ + 256 * 1024, WS_SSKR = WS_RSTDKV + 256 * 1024, WS_ROPE = 809 * MiB, WS_SSQ2 = 810 * MiB,
                 WS_MISC = 814 * MiB, WS_SSUM2 = WS_MISC + 64 * 1024, WS_SSQ4 = 815 * MiB, WS_SSKV4 = 816 * MiB, WS_SSKR2 = 817 * MiB, WS_S0 = 832 * MiB, WS_BAR = 960 * MiB, WS_END = 961 * MiB;
struct Params {
    const float *x, *attn_norm_w, *w_in, *q_a_norm_w, *w_uq, *kv_a_norm_w, *w_ukv, *mla_q_norm_w, *mla_k_norm_w, *diff_q_norm_w, *diff_k_norm_w,
                *lambda_q1, *lambda_k1, *lambda_q2, *lambda_k2, *diff_out_norm_w, *w_out, *mlp_norm_w, *w_up, *w_down, *rel_bias;
    float* out; unsigned char* ws;
};
DI float bf2f(unsigned short h) { return __uint_as_float((unsigned)h << 16); }
DI unsigned short f2bf(float x) { unsigned u = __float_as_uint(x); u += 0x7fffu + ((u >> 16) & 1u); return (unsigned short)(u >> 16); }
DI float shx(float v, int mask, int lane) { return __int_as_float(__builtin_amdgcn_ds_bpermute((lane ^ mask) << 2, __float_as_int(v))); }
DI float shl_from(float v, int src) { return __int_as_float(__builtin_amdgcn_ds_bpermute(src << 2, __float_as_int(v))); }
DI float wave_sum(float v, int lane) {
#pragma unroll
    for (int m = 32; m >= 1; m >>= 1) v += shx(v, m, lane);
    return v;
}

struct EpiProj {
    static constexpr bool PERM = true, AFTER_DRAIN = false;
    bf16_t* O; const float* rs; float* ssq4; float* sskv4; float* sskr2; float* KR; const float* cs; const float* sn; const float* gdq; const float* gdk;
    DI void operator()(const f32x4 (&acc)[2][2][4][2], const Unit& u, int wr, int wc, int fr, int fq) const {
        const int row0 = u.pm * 256 + wr * 64 + fr, pn = u.pn, ln = fq * 16 + fr;
        if (pn >= 2 && pn < 6) {
            const float* gp = pn < 4 ? gdq : gdk; const float gsc = pn < 4 ? 0.125f * LOG2E : 1.f;
            f32x4 g[2][2];
#pragma unroll
            for (int bj = 0; bj < 2; ++bj)
#pragma unroll
                for (int n = 0; n < 2; ++n) g[bj][n] = *(const f32x4*)(gp + 32 * bj + 8 * fq + 4 * n) * gsc;
#pragma unroll
            for (int ai = 0; ai < 2; ++ai)
#pragma unroll
                for (int m = 0; m < 4; ++m) { const int row = row0 + ai * 128 + m * 16; const float s = rs[row]; float ss = 0.f;
#pragma unroll
                    for (int bj = 0; bj < 2; ++bj)
#pragma unroll
                        for (int n = 0; n < 2; ++n) { const f32x4 v = acc[ai][bj][m][n]; ss += (v[0] * v[0] + v[1] * v[1]) + (v[2] * v[2] + v[3] * v[3]); }
                    ss += shx(ss, 16, ln); ss += shx(ss, 32, ln);
                    const float r = s * rsqrtf(ss * s * s * (1.f / 64.f) + EPS);
                    bf16_t* rowp = O + (size_t)row * 2048 + pn * 256 + 64 * wc + 8 * fq;
#pragma unroll
                    for (int bj = 0; bj < 2; ++bj) { const f32x4 v0 = acc[ai][bj][m][0] * r * g[bj][0], v1 = acc[ai][bj][m][1] * r * g[bj][1]; u32x4 w;
                        w.x = cvt_pk_bf16(v0[0], v0[1]); w.y = cvt_pk_bf16(v0[2], v0[3]); w.z = cvt_pk_bf16(v1[0], v1[1]); w.w = cvt_pk_bf16(v1[2], v1[3]);
                        *(u32x4*)(rowp + 32 * bj) = w; } }
            return;
        }
        const int col0 = pn * 256 + wc * 32 + 8 * fq;
#pragma unroll
        for (int ai = 0; ai < 2; ++ai)
#pragma unroll
            for (int m = 0; m < 4; ++m) { const int row = row0 + ai * 128 + m * 16; const float s = rs[row]; bf16_t* rowp = O + (size_t)row * 2048 + col0;
                f32x4 v[2][2];
#pragma unroll
                for (int bj = 0; bj < 2; ++bj) { v[bj][0] = acc[ai][bj][m][0] * s; v[bj][1] = acc[ai][bj][m][1] * s; u32x4 w;
                    w.x = cvt_pk_bf16(v[bj][0][0], v[bj][0][1]); w.y = cvt_pk_bf16(v[bj][0][2], v[bj][0][3]); w.z = cvt_pk_bf16(v[bj][1][0], v[bj][1][1]); w.w = cvt_pk_bf16(v[bj][1][2], v[bj][1][3]);
                    *(u32x4*)(rowp + bj * 128) = w; }
                if (pn < 2) {
                    float s0 = 0.f, s1 = 0.f;
#pragma unroll
                    for (int n = 0; n < 2; ++n) { s0 += (v[0][n][0] * v[0][n][0] + v[0][n][1] * v[0][n][1]) + (v[0][n][2] * v[0][n][2] + v[0][n][3] * v[0][n][3]);
                                                  s1 += (v[1][n][0] * v[1][n][0] + v[1][n][1] * v[1][n][1]) + (v[1][n][2] * v[1][n][2] + v[1][n][3] * v[1][n][3]); }
                    if (pn == 0) { float ss = s0 + s1; ss += shx(ss, 16, ln); ss += shx(ss, 32, ln); if (fq == 0) ssq4[(size_t)row * 4 + wc] = ss; }
                    else { s0 += shx(s0, 16, ln); s0 += shx(s0, 32, ln); if (fq == 0) sskv4[(size_t)row * 4 + wc] = s0;
                        if (wc < 2) { s1 += shx(s1, 16, ln); s1 += shx(s1, 32, ln); if (fq == 0) sskr2[(size_t)row * 2 + wc] = s1;
                            const int i0 = 16 * wc + 4 * fq, pos = row & (SEQ - 1); const f32x4 c = *(const f32x4*)(cs + pos * 32 + i0), sv = *(const f32x4*)(sn + pos * 32 + i0);
                            *(f32x4*)(KR + (size_t)row * 64 + i0) = v[1][0] * c - v[1][1] * sv; *(f32x4*)(KR + (size_t)row * 64 + 32 + i0) = v[1][1] * c + v[1][0] * sv; } } } }
    }
};
struct EpiQ {
    static constexpr bool PERM = true, AFTER_DRAIN = false;
    bf16_t* Q; const float* ssq4; const float* cs; const float* sn;
    DI void operator()(const f32x4 (&acc)[2][2][4][2], const Unit& u, int wr, int wc, int fr, int fq) const {
        const int row0 = u.pm * 256 + wr * 64 + fr;
#pragma unroll
        for (int ai = 0; ai < 2; ++ai)
#pragma unroll
            for (int m = 0; m < 4; ++m) { const int row = row0 + ai * 128 + m * 16; const f32x4 q4 = *(const f32x4*)(ssq4 + (size_t)row * 4);
                const float s = rsqrtf(((q4[0] + q4[1]) + (q4[2] + q4[3])) * (1.f / 256.f) + EPS); bf16_t* rowp = Q + (size_t)row * 768;
#pragma unroll
                for (int bj = 0; bj < 2; ++bj) { const int c0 = u.pn * 256 + bj * 128 + wc * 32, h = c0 / 192, d0 = c0 - h * 192;
                    if (d0 < 128) { const f32x4 v0 = acc[ai][bj][m][0] * s, v1 = acc[ai][bj][m][1] * s; u32x4 w;
                        w.x = cvt_pk_bf16(v0[0], v0[1]); w.y = cvt_pk_bf16(v0[2], v0[3]); w.z = cvt_pk_bf16(v1[0], v1[1]); w.w = cvt_pk_bf16(v1[2], v1[3]);
                        *(u32x4*)(rowp + c0 + 8 * fq) = w; }
                    else { const int i0 = 16 * (wc & 1) + 4 * fq, pos = row & (SEQ - 1);
                        const f32x4 c = *(const f32x4*)(cs + pos * 32 + i0), sv = *(const f32x4*)(sn + pos * 32 + i0);
                        const f32x4 x1 = acc[ai][bj][m][0] * s, x2 = acc[ai][bj][m][1] * s; const f32x4 o1 = x1 * c - x2 * sv, o2 = x2 * c + x1 * sv; u32x2 a, b;
                        a.x = cvt_pk_bf16(o1[0], o1[1]); a.y = cvt_pk_bf16(o1[2], o1[3]); b.x = cvt_pk_bf16(o2[0], o2[1]); b.y = cvt_pk_bf16(o2[2], o2[3]);
                        *(u32x2*)(rowp + h * 192 + 128 + i0) = a; *(u32x2*)(rowp + h * 192 + 160 + i0) = b; } } }
    }
};
struct EpiKV {
    static constexpr bool PERM = true, AFTER_DRAIN = false;
    bf16_t* KM; bf16_t* V; const float* sskv4; const float* KR; const float* sskr2; const float* gk; LAS float* part;
    DI float rsrow(int row) const { const f32x4 q4 = *(const f32x4*)(sskv4 + (size_t)row * 4); return rsqrtf(((q4[0] + q4[1]) + (q4[2] + q4[3])) * (1.f / 128.f) + EPS); }
    DI void operator()(const f32x4 (&acc)[2][2][4][2], const Unit& u, int wr, int wc, int fr, int fq) const {
        const int row0 = u.pm * 256 + wr * 64 + fr, h = u.pn, cw = wc * 32 + 8 * fq, ln = fq * 16 + fr;
#pragma unroll
        for (int ai = 0; ai < 2; ++ai)
#pragma unroll
            for (int m = 0; m < 4; ++m) { const int row = row0 + ai * 128 + m * 16; const float s = rsrow(row);
                const f32x4 w0 = acc[ai][1][m][0] * s, w1 = acc[ai][1][m][1] * s; u32x4 w;
                w.x = cvt_pk_bf16(w0[0], w0[1]); w.y = cvt_pk_bf16(w0[2], w0[3]); w.z = cvt_pk_bf16(w1[0], w1[1]); w.w = cvt_pk_bf16(w1[2], w1[3]);
                *(u32x4*)(V + (size_t)row * 512 + h * 128 + cw) = w; }
        asm volatile("" ::: "memory");
#pragma unroll
        for (int ai = 0; ai < 2; ++ai)
#pragma unroll
            for (int m = 0; m < 4; ++m) { const int row = row0 + ai * 128 + m * 16; const float s = rsrow(row);
                const f32x4 v0 = acc[ai][0][m][0] * s, v1 = acc[ai][0][m][1] * s;
                float ss = ((v0[0] * v0[0] + v0[1] * v0[1]) + (v0[2] * v0[2] + v0[3] * v0[3])) + ((v1[0] * v1[0] + v1[1] * v1[1]) + (v1[2] * v1[2] + v1[3] * v1[3]));
                ss += shx(ss, 16, ln); ss += shx(ss, 32, ln);
                if (fq == 0) part[(ai * 128 + wr * 64 + m * 16 + fr) * 4 + wc] = ss; }
        asm volatile("s_waitcnt lgkmcnt(0)" ::: "memory"); __builtin_amdgcn_s_barrier(); asm volatile("" ::: "memory");
#pragma unroll
        for (int ai = 0; ai < 2; ++ai)
#pragma unroll
            for (int m = 0; m < 4; ++m) { const int row = row0 + ai * 128 + m * 16; const f32x4 pp = *(const LAS f32x4*)(part + (ai * 128 + wr * 64 + m * 16 + fr) * 4);
                const float rstd = rsqrtf((((pp[0] + pp[1]) + (pp[2] + pp[3])) + (sskr2[(size_t)row * 2] + sskr2[(size_t)row * 2 + 1])) * (1.f / 192.f) + EPS), s = rsrow(row) * rstd;
                const f32x4 g0 = *(const f32x4*)(gk + cw), g1 = *(const f32x4*)(gk + cw + 4), gr = *(const f32x4*)(gk + 128 + wc * 16 + fq * 4);
                const f32x4 v0 = acc[ai][0][m][0] * s * g0, v1 = acc[ai][0][m][1] * s * g1; u32x4 w;
                w.x = cvt_pk_bf16(v0[0], v0[1]); w.y = cvt_pk_bf16(v0[2], v0[3]); w.z = cvt_pk_bf16(v1[0], v1[1]); w.w = cvt_pk_bf16(v1[2], v1[3]);
                bf16_t* kp = KM + (size_t)row * 768 + h * 192;
                *(u32x4*)(kp + cw) = w;
                const f32x4 kr = *(const f32x4*)(KR + (size_t)row * 64 + wc * 16 + fq * 4) * rstd * gr; u32x2 r2; r2.x = cvt_pk_bf16(kr[0], kr[1]); r2.y = cvt_pk_bf16(kr[2], kr[3]);
                *(u32x2*)(kp + 128 + wc * 16 + fq * 4) = r2; asm volatile("" ::: "memory"); }
    }
};
struct EpiOut {
    static constexpr bool PERM = true, AFTER_DRAIN = false;
    bf16_t* x1b; float* ssum2;
    DI void operator()(const f32x4 (&acc)[2][2][4][2], const Unit& u, int wr, int wc, int fr, int fq) const {
        const int row0 = u.pm * 256 + wr * 64 + fr, col0 = u.pn * 256 + wc * 32 + 8 * fq;
#pragma unroll
        for (int ai = 0; ai < 2; ++ai)
#pragma unroll
            for (int m = 0; m < 4; ++m) { const int row = row0 + ai * 128 + m * 16; const size_t off = (size_t)row * 1024 + col0; float ss = 0.f;
#pragma unroll
                for (int bj = 0; bj < 2; ++bj) { const size_t o = off + bj * 128; const u32x4 r_ = *(const u32x4*)(x1b + o); f32x4 v0, v1;
                    v0[0] = __uint_as_float(r_.x << 16); v0[1] = __uint_as_float(r_.x & 0xffff0000u); v0[2] = __uint_as_float(r_.y << 16); v0[3] = __uint_as_float(r_.y & 0xffff0000u);
                    v1[0] = __uint_as_float(r_.z << 16); v1[1] = __uint_as_float(r_.z & 0xffff0000u); v1[2] = __uint_as_float(r_.w << 16); v1[3] = __uint_as_float(r_.w & 0xffff0000u);
                    v0 = v0 + acc[ai][bj][m][0]; v1 = v1 + acc[ai][bj][m][1];
                    ss += ((v0[0] * v0[0] + v0[1] * v0[1]) + (v0[2] * v0[2] + v0[3] * v0[3])) + ((v1[0] * v1[0] + v1[1] * v1[1]) + (v1[2] * v1[2] + v1[3] * v1[3]));
                    u32x4 w; w.x = cvt_pk_bf16(v0[0], v0[1]); w.y = cvt_pk_bf16(v0[2], v0[3]); w.z = cvt_pk_bf16(v1[0], v1[1]); w.w = cvt_pk_bf16(v1[2], v1[3]); *(u32x4*)(x1b + o) = w; }
                { const int ln_ = fq * 16 + fr; ss += shx(ss, 16, ln_); ss += shx(ss, 32, ln_); }
                if (fq == 0) unsafeAtomicAdd(ssum2 + row, ss); }
    }
};
struct EpiUp {
    static constexpr bool PERM = true, AFTER_DRAIN = false;
    bf16_t* U; const float* ssum2;
    DI void operator()(const f32x4 (&acc)[2][2][4][2], const Unit& u, int wr, int wc, int fr, int fq) const {
        const int row0 = u.pm * 256 + wr * 64 + fr, col0 = u.pn * 256 + wc * 64 + 8 * fq;
#pragma unroll
        for (int ai = 0; ai < 2; ++ai)
#pragma unroll
            for (int m = 0; m < 4; ++m) { const int row = row0 + ai * 128 + m * 16; const float s = rsqrtf(ssum2[row] * (1.f / 1024.f) + EPS);
                bf16_t* rowp = U + (size_t)row * 4096 + col0;
#pragma unroll
                for (int bj = 0; bj < 2; ++bj) { f32x4 v0 = acc[ai][bj][m][0] * s, v1 = acc[ai][bj][m][1] * s;
#pragma unroll
                    for (int j = 0; j < 4; ++j) { const float a = fmaxf(v0[j], 0.f), b = fmaxf(v1[j], 0.f); v0[j] = a * a; v1[j] = b * b; }
                    u32x4 w; w.x = cvt_pk_bf16(v0[0], v0[1]); w.y = cvt_pk_bf16(v0[2], v0[3]); w.z = cvt_pk_bf16(v1[0], v1[1]); w.w = cvt_pk_bf16(v1[2], v1[3]);
                    __builtin_nontemporal_store(w, (u32x4*)(rowp + bj * 32)); } }
    }
};
struct EpiDown {
    static constexpr bool PERM = true, AFTER_DRAIN = false;
    float* out; const bf16_t* x1b;
    DI void operator()(const f32x4 (&acc)[2][2][4][2], const Unit& u, int wr, int wc, int fr, int fq) const {
        const int row0 = u.pm * 256 + wr * 64 + fr, col0 = u.pn * 256 + wc * 32 + 8 * fq;
#pragma unroll
        for (int ai = 0; ai < 2; ++ai)
#pragma unroll
            for (int m = 0; m < 4; ++m) { const size_t off = (size_t)(row0 + ai * 128 + m * 16) * 1024 + col0;
#pragma unroll
                for (int bj = 0; bj < 2; ++bj) { const size_t o = off + bj * 128; const u32x4 r = *(const u32x4*)(x1b + o); f32x4 v0, v1;
                    v0[0] = __uint_as_float(r.x << 16); v0[1] = __uint_as_float(r.x & 0xffff0000u); v0[2] = __uint_as_float(r.y << 16); v0[3] = __uint_as_float(r.y & 0xffff0000u);
                    v1[0] = __uint_as_float(r.z << 16); v1[1] = __uint_as_float(r.z & 0xffff0000u); v1[2] = __uint_as_float(r.w << 16); v1[3] = __uint_as_float(r.w & 0xffff0000u);
                    __builtin_nontemporal_store(v0 + acc[ai][bj][m][0], (f32x4*)(out + o)); __builtin_nontemporal_store(v1 + acc[ai][bj][m][1], (f32x4*)(out + o + 4)); } }
    }
};
namespace att {
typedef short bf16x8 __attribute__((ext_vector_type(8)));
typedef short s16x4 __attribute__((ext_vector_type(4)));
typedef float f32x16 __attribute__((ext_vector_type(16)));
constexpr int SHM_V = 16384, KBUF_MAX = 64 * 192 * 2, V_OFF = 4 * KBUF_MAX, WS_OFF = V_OFF + 3 * SHM_V, BT_OFF = WS_OFF + 8 * 64 * 4, ATT_LDS = BT_OFF + 1800;
#define SBAR() __builtin_amdgcn_sched_barrier(0)
DI int crow(int r, int hi) { return (r & 3) + 8 * (r >> 2) + 4 * hi; }
DI unsigned cvtpk(float lo, float hi) { unsigned r; asm volatile("v_cvt_pk_bf16_f32 %0, %1, %2" : "=v"(r) : "v"(lo), "v"(hi)); return r; }
template <int DQK> DI int kswz(int row, int colB) { return row * (DQK * 2) + (colB ^ (((row >> 1) & 7) << 4)); }
DI float swap_sum(float v) { auto rr = __builtin_amdgcn_permlane32_swap(__float_as_uint(v), __float_as_uint(v), false, false); return __uint_as_float(rr[0]) + __uint_as_float(rr[1]); }

DI void expsum(f32x16& p, float& l_reg, bf16x8& pa0, bf16x8& pa1) {
#pragma unroll
    for (int r = 0; r < 16; ++r) p[r] = __builtin_amdgcn_exp2f(p[r]);
    float ps = 0.f;
#pragma unroll
    for (int r = 0; r < 16; ++r) ps += p[r];
    l_reg += ps; asm volatile("" : "+v"(l_reg));
#define ATT_PK4(P, BASE, OUT) do { unsigned a0 = cvtpk(P[BASE + 0], P[BASE + 1]), a1 = cvtpk(P[BASE + 2], P[BASE + 3]);   \
    unsigned b0 = cvtpk(P[BASE + 4], P[BASE + 5]), b1 = cvtpk(P[BASE + 6], P[BASE + 7]);                              \
    auto r0 = __builtin_amdgcn_permlane32_swap(a0, b0, false, false); auto r1 = __builtin_amdgcn_permlane32_swap(a1, b1, false, false); \
    u32x4 w = {r0[0], r1[0], r0[1], r1[1]}; OUT = __builtin_bit_cast(bf16x8, w); } while (0)
    ATT_PK4(p, 0, pa0); ATT_PK4(p, 8, pa1);
#undef ATT_PK4
}
DI int v_rd_base(int lane) { return ((lane & 3) << 3) | (((lane >> 2) & 3) << 6) | (((lane >> 4) & 1) << 5) | (((lane >> 5) & 1) << 8); }
constexpr int v_rd_off(int d0, int ks, int half) { return d0 * 512 + ks * 4096 + half * 2048; }
template <int OFF> DI s16x4 tr_read(int vb) { s16x4 r; asm volatile("ds_read_b64_tr_b16 %0, %1 offset:%2" : "=&v"(r) : "v"(vb), "i"(OFF) : "memory"); return r; }
template <int H> DI void v_reads(s16x4* vf, int vb) {
    vf[0] = tr_read<v_rd_off(0, 2 * H, 0)>(vb); vf[1] = tr_read<v_rd_off(0, 2 * H, 1)>(vb); vf[2] = tr_read<v_rd_off(0, 2 * H + 1, 0)>(vb); vf[3] = tr_read<v_rd_off(0, 2 * H + 1, 1)>(vb);
    vf[4] = tr_read<v_rd_off(1, 2 * H, 0)>(vb); vf[5] = tr_read<v_rd_off(1, 2 * H, 1)>(vb); vf[6] = tr_read<v_rd_off(1, 2 * H + 1, 0)>(vb); vf[7] = tr_read<v_rd_off(1, 2 * H + 1, 1)>(vb);
    vf[8] = tr_read<v_rd_off(2, 2 * H, 0)>(vb); vf[9] = tr_read<v_rd_off(2, 2 * H, 1)>(vb); vf[10] = tr_read<v_rd_off(2, 2 * H + 1, 0)>(vb); vf[11] = tr_read<v_rd_off(2, 2 * H + 1, 1)>(vb);
    vf[12] = tr_read<v_rd_off(3, 2 * H, 0)>(vb); vf[13] = tr_read<v_rd_off(3, 2 * H, 1)>(vb); vf[14] = tr_read<v_rd_off(3, 2 * H + 1, 0)>(vb); vf[15] = tr_read<v_rd_off(3, 2 * H + 1, 1)>(vb);
}
DI void pv_mma(f32x16* o, const s16x4* vf, bf16x8 pa0, bf16x8 pa1) {
#define ATT_PK(L, H_) (bf16x8){L[0], L[1], L[2], L[3], H_[0], H_[1], H_[2], H_[3]}
#pragma unroll
    for (int d0 = 0; d0 < 4; ++d0) {
        o[d0] = __builtin_amdgcn_mfma_f32_32x32x16_bf16(pa0, ATT_PK(vf[4 * d0], vf[4 * d0 + 1]), o[d0], 0, 0, 0);
        o[d0] = __builtin_amdgcn_mfma_f32_32x32x16_bf16(pa1, ATT_PK(vf[4 * d0 + 2], vf[4 * d0 + 3]), o[d0], 0, 0, 0); }
#undef ATT_PK
}
template <int DQK, int D0A, int D0B> DI void k_reads(bf16x8* kf, const LAS unsigned char* Ks, int half, int r32, int hi) {
#pragma unroll
    for (int d0 = D0A; d0 < D0B; ++d0) kf[d0 - D0A] = *(const LAS bf16x8*)(Ks + half * (32 * DQK * 2) + kswz<DQK>(r32, (d0 * 16 + hi * 8) * 2));
}
template <int D0A, int D0B> DI void qk_mma(f32x16& p, const bf16x8* kf, const bf16x8* qr) {
#pragma unroll
    for (int d0 = D0A; d0 < D0B; ++d0) {
        if (d0 == 0) { f32x16 z; _Pragma("unroll") for (int r = 0; r < 16; ++r) z[r] = 0.f; p = __builtin_amdgcn_mfma_f32_32x32x16_bf16(kf[0], qr[0], z, 0, 0, 0); }
        else p = __builtin_amdgcn_mfma_f32_32x32x16_bf16(kf[d0 - D0A], qr[d0], p, 0, 0, 0); }
}

template <int DQK, int MODE, int LDQ, int LDK, int LDV>
DI void attn_body(const bf16_t* __restrict__ Qb, const bf16_t* __restrict__ Kh, const bf16_t* __restrict__ Vh, int q0, float C, const float* __restrict__ gq,
                  float* S0, bf16_t* AOb, float lam, const float* __restrict__ gout, LAS unsigned char* lds, int wv) {
    constexpr int KBUF = 64 * DQK * 2, CPR = DQK / 8, NKP = KBUF / 8192, ND0 = DQK / 16, NT = SEQ / 64;
    int tid_ = fresh_tid<100 + MODE>(wv); const int tid = tid_, wid = __builtin_amdgcn_readfirstlane(tid >> 6), lane = tid & 63, r32 = lane & 31, hi = lane >> 5;
    LAS float* ws = (LAS float*)(lds + WS_OFF) + wid * 64; LAS float* li_l = ws;
    const LAS float* bt = (const LAS float*)(lds + BT_OFF);
    float l_reg = 0.f; f32x16 o[4];
#pragma unroll
    for (int d = 0; d < 4; ++d)
#pragma unroll
        for (int r = 0; r < 16; ++r) o[d][r] = 0.f;
    int kgo[NKP], vgo[2];
#pragma unroll
    for (int i = 0; i < NKP; ++i) { const int L = (wid + 8 * i) * 64 + lane, row = L / CPR, slot = L % CPR, cc = (slot & ~7) | ((slot & 7) ^ ((row >> 1) & 7)); kgo[i] = row * LDK + cc * 8; }
#pragma unroll
    for (int i = 0; i < 2; ++i) { const int L = (2 * wid + i) * 64 + lane, st = L >> 5, w5 = L & 31, kk = (st >> 2) * 8 + (w5 >> 2), c = (st & 3) * 32 + (w5 & 3) * 8;
        const int k = (kk & ~0xC) | ((kk & 4) << 1) | ((kk & 8) >> 1); vgo[i] = k * LDV + c; }
#define ATT_DMA_K(t) do { const bf16_t* kg_ = Kh + (size_t)(t) * 64 * LDK; LAS unsigned char* sb_ = lds + ((t) & 3) * KBUF; \
    _Pragma("unroll") for (int i_ = 0; i_ < NKP; ++i_) __builtin_amdgcn_global_load_lds((const unsigned*)(kg_ + kgo[i_]), (LAS unsigned*)(sb_ + (wid + 8 * i_) * 1024), 16, 0, 0); } while (0)
#define ATT_DMA_V(t, vs) do { const bf16_t* vg_ = Vh + (size_t)(t) * 64 * LDV; LAS unsigned char* sb_ = lds + V_OFF + (vs) * SHM_V; \
    _Pragma("unroll") for (int i_ = 0; i_ < 2; ++i_) __builtin_amdgcn_global_load_lds((const unsigned*)(vg_ + vgo[i_]), (LAS unsigned*)(sb_ + (2 * wid + i_) * 1024), 16, 0, 0); } while (0)
    ATT_DMA_K(0); ATT_DMA_K(1); ATT_DMA_V(0, 0); ATT_DMA_K(2); ATT_DMA_V(1, 1);
    bf16x8 qr[ND0];
    { const bf16_t* Qw = Qb + (size_t)(wid * 32 + r32) * LDQ + hi * 8;
#pragma unroll
      for (int d0 = 0; d0 < ND0; ++d0) qr[d0] = *(const bf16x8*)(Qw + d0 * 16);
      if constexpr (MODE == 0) {
          float ss = 0.f;
#pragma unroll
          for (int d0 = 0; d0 < ND0; ++d0)
#pragma unroll
              for (int j = 0; j < 8; ++j) { const float f = bf2f((unsigned short)qr[d0][j]); ss += f * f; }
          ss = swap_sum(ss);
          const float rstd = rsqrtf(ss * (1.f / DQK) + EPS) * C;
#pragma unroll
          for (int d0 = 0; d0 < ND0; ++d0) { const float* g = gq + d0 * 16 + hi * 8;
              { float f[8]; _Pragma("unroll") for (int j = 0; j < 8; ++j) f[j] = bf2f((unsigned short)qr[d0][j]) * rstd * g[j];
                u32x4 w = {cvtpk(f[0], f[1]), cvtpk(f[2], f[3]), cvtpk(f[4], f[5]), cvtpk(f[6], f[7])}; qr[d0] = __builtin_bit_cast(bf16x8, w); asm volatile("" ::: "memory"); } }
      } }
    const int qlo = q0 + wid * 32, qpos = qlo + r32;
    const int tL = MODE == 0 ? 0 : (qlo >= 191 ? (qlo - 127) >> 6 : 0), tR = MODE == 0 ? NT : min(NT, (qlo + 222) >> 6);
    float fL = 1.f, fR = 1.f; if constexpr (MODE != 0) { fL = __builtin_amdgcn_exp2f(bt[0]); fR = __builtin_amdgcn_exp2f(-bt[448]); }
#define ATT_SEG(t) do { if constexpr (MODE != 0) { if (((t) == tL && tL > 0) || (t) == tR) { const float f_ = (t) == tR ? fR : fL; l_reg *= f_; \
    _Pragma("unroll") for (int d = 0; d < 4; ++d) _Pragma("unroll") for (int r = 0; r < 16; ++r) o[d][r] *= f_; } } } while (0)
#define ATT_BIAS(P, t, half) do { if constexpr (MODE != 0) { if ((t) >= tL && (t) < tR) { const LAS float* bp_ = bt + ((t) * 64 + (half) * 32 - qpos + 224 + 4 * hi);     \
    _Pragma("unroll") for (int r = 0; r < 16; ++r) P[r] += bp_[(r & 3) + 8 * (r >> 2)]; } } } while (0)
    const int vbase = (int)(unsigned)(size_t)lds + V_OFF + v_rd_base(lane);
#define ATT_TOP(N) do { asm volatile("s_waitcnt vmcnt(%0)" :: "n"(N) : "memory"); __builtin_amdgcn_s_barrier(); asm volatile("" ::: "memory"); } while (0)
#define ATT_LGKM0() do { SBAR(); asm volatile("s_waitcnt lgkmcnt(0)" ::: "memory"); SBAR(); } while (0)
    constexpr int NDA = ND0 > 6 ? 6 : ND0;
#define ATT_STEP(PC, PN, H, SV, DO_NEXT, HN, TN) do { bf16x8 kf[NDA]; s16x4 vf[16]; const LAS unsigned char* ks_ = lds + ((TN) & 3) * KBUF; \
        if (DO_NEXT) k_reads<DQK, 0, NDA>(kf, ks_, HN, r32, hi); \
        v_reads<H>(vf, vbase + (SV) * SHM_V); SBAR(); \
        expsum(PC, l_reg, pa0, pa1); SBAR(); ATT_LGKM0(); \
        if constexpr (ND0 > NDA) { bf16x8 kg[ND0 - NDA]; if (DO_NEXT) k_reads<DQK, NDA, ND0>(kg, ks_, HN, r32, hi); SBAR(); \
            pv_mma(o, vf, pa0, pa1); if (DO_NEXT) { qk_mma<0, NDA>(PN, kf, qr); ATT_LGKM0(); qk_mma<NDA, ND0>(PN, kg, qr); } } \
        else { pv_mma(o, vf, pa0, pa1); if (DO_NEXT) qk_mma<0, NDA>(PN, kf, qr); } \
        if (DO_NEXT) ATT_BIAS(PN, TN, HN); SBAR(); } while (0)
    f32x16 pA, pB; bf16x8 pa0, pa1;
    int v0 = 0, v1 = 1, v2 = 2;
    ATT_TOP(NKP + 2);
    { bf16x8 kf[NDA]; k_reads<DQK, 0, NDA>(kf, lds, 0, r32, hi); ATT_LGKM0(); qk_mma<0, NDA>(pA, kf, qr);
      if constexpr (ND0 > NDA) { bf16x8 kg[ND0 - NDA]; k_reads<DQK, NDA, ND0>(kg, lds, 0, r32, hi); ATT_LGKM0(); qk_mma<NDA, ND0>(pA, kg, qr); }
      ATT_BIAS(pA, 0, 0); }
    if (wid >= 4) __builtin_amdgcn_s_setprio(1);
    for (int j = 0; j < NT; ++j) {
        if (j + 2 < NT) ATT_TOP(NKP + 2); else ATT_TOP(0);
        if (j + 3 < NT) ATT_DMA_K(j + 3);
        if (j + 2 < NT) ATT_DMA_V(j + 2, v2);
        ATT_SEG(j); SBAR();
        ATT_STEP(pA, pB, 0, v0, true, 1, j);
        ATT_STEP(pB, pA, 1, v0, (j + 1 < NT), 0, j + 1);
        { const int t_ = v0; v0 = v1; v1 = v2; v2 = t_; }
    }
    __builtin_amdgcn_s_setprio(0);
#undef ATT_STEP
#undef ATT_LGKM0
    l_reg = swap_sum(l_reg);
    { const int lane2 = fresh_tid<110 + MODE>(wv) & 63, r32 = lane2 & 31, hi = lane2 >> 5;
    if (hi == 0) li_l[r32] = l_reg;
    asm volatile("s_waitcnt lgkmcnt(0)" ::: "memory");
    float s0v[MODE == 2 ? 16 : 1][4];
    if constexpr (MODE == 2) {
#pragma unroll
        for (int r = 0; r < 16; ++r)
#pragma unroll
            for (int d0 = 0; d0 < 4; ++d0) s0v[r][d0] = S0[(size_t)(wid * 32 + crow(r, hi)) * 512 + d0 * 32 + r32];
    }
#pragma unroll
    for (int r = 0; r < 16; ++r) { const int orow = wid * 32 + crow(r, hi); const float rl = __builtin_amdgcn_rcpf(li_l[crow(r, hi)]);
        if constexpr (MODE == 0) {
#pragma unroll
            for (int d0 = 0; d0 < 4; ++d0) AOb[(size_t)orow * 1024 + d0 * 32 + r32] = f2bf(o[d0][r] * rl);
        } else if constexpr (MODE == 1) {
#pragma unroll
            for (int d0 = 0; d0 < 4; ++d0) S0[(size_t)orow * 512 + d0 * 32 + r32] = o[d0][r] * rl;
        } else {
            float v[4]; float ss = 0.f;
#pragma unroll
            for (int d0 = 0; d0 < 4; ++d0) { v[d0] = s0v[r][d0] - lam * (o[d0][r] * rl); ss += v[d0] * v[d0]; }
#pragma unroll
            for (int mk = 1; mk <= 16; mk <<= 1) ss += shx(ss, mk, lane2);
            const float rs = rsqrtf(ss * (1.f / 128.f) + EPS) * 0.8f;
#pragma unroll
            for (int d0 = 0; d0 < 4; ++d0) AOb[(size_t)orow * 1024 + d0 * 32 + r32] = f2bf(v[d0] * rs * gout[d0 * 32 + r32]);
        } }
    }
#undef ATT_DMA_K
#undef ATT_DMA_V
#undef ATT_SEG
#undef ATT_BIAS
#undef ATT_TOP
}
}
struct MapIn  { DI int operator()(int n) const {
                    if (n < 384) return n;
                    if (n < 512) { const int u = n - 384; if (u >= 64) return -1; const int wc = u >> 5, fq = (u >> 3) & 3, nn = (u >> 2) & 1, j = u & 3; return 384 + nn * 32 + 16 * wc + 4 * fq + j; }
                    if (n < 1536) { const int t = n & 255, tb = n - t, bj = t >> 7, wc = (t >> 5) & 3, u = t & 31; return tb + 64 * wc + 32 * bj + u - 64; }
                    return n - 64; } };
struct MapUq  { DI int operator()(int n) const { const int h = n / 192, d = n - h * 192; if (d < 128) return n;
                    const int u = d - 128, w = u >> 5, fq = (u >> 3) & 3, nn = (u >> 2) & 1, j = u & 3; return h * 192 + 128 + nn * 32 + 16 * w + 4 * fq + j; } };
struct MapId  { DI int operator()(int n) const { return n; } };
struct MapW64 { DI int operator()(int n) const { const int t = n & 255, tb = n - t, bj = t >> 7, wc = (t >> 5) & 3, u = t & 31; return tb + 64 * wc + 32 * bj + u; } };
template <class ColMap>
DI void transpose_w(LAS float* tile, const float* __restrict__ w, int Ksrc, int Nsrc, const float* __restrict__ gain, bf16_t* __restrict__ out, int Nout, int Kout, ColMap cm, int gw, int ngw, int lane) {
    const int tilesK = Kout / 64, ntile = tilesK * (Nout / 64);
    for (int t = gw; t < ntile; t += ngw) { const int k0 = (t % tilesK) * 64, n0 = (t / tilesK) * 64; const int scol = cm(n0 + lane);
#pragma unroll
        for (int c = 0; c < 4; ++c) { float v[16];
#pragma unroll
            for (int i = 0; i < 16; ++i) { const int k = k0 + c * 16 + i; v[i] = (scol >= 0 && k < Ksrc) ? w[(size_t)k * Nsrc + scol] * (gain ? gain[k] : 1.f) : 0.f; }
#pragma unroll
            for (int i = 0; i < 16; ++i) tile[(c * 16 + i) * 65 + lane] = v[i]; }
        asm volatile("s_waitcnt lgkmcnt(0)" ::: "memory");
#pragma unroll 8
        for (int nl = 0; nl < 64; ++nl) out[(size_t)(n0 + nl) * Kout + k0 + lane] = f2bf(tile[lane * 65 + nl]);
        asm volatile("s_waitcnt lgkmcnt(0)" ::: "memory"); }
}
DI void phase0(const Params& p, LAS unsigned char* lds, int wv) {
    int tid_ = fresh_tid<1>(wv); const int tid = tid_, bid = blockIdx.x, nb = gridDim.x, wave = tid >> 6, lane = tid & 63;
    unsigned char* ws = p.ws; LAS float* tile = (LAS float*)lds + wave * (64 * 65);
    const int ngw = nb * 8, gw = bid * 8 + wave;
    transpose_w(tile, p.w_up, 1024, 4096, p.mlp_norm_w, (bf16_t*)(ws + WS_WUP), 4096, 1024, MapW64(), gw, ngw, lane);
    transpose_w(tile, p.w_down, 4096, 1024, nullptr, (bf16_t*)(ws + WS_WDN), 1024, 4096, MapId(), (gw + ngw / 2) % ngw, ngw, lane);
    transpose_w(tile, p.w_in, 1024, 1984, p.attn_norm_w, (bf16_t*)(ws + WS_WIN), 2048, 1024, MapIn(), (gw + ngw / 4) % ngw, ngw, lane);
    transpose_w(tile, p.w_out, 1024, 1024, nullptr, (bf16_t*)(ws + WS_WOUT), 1024, 1024, MapId(), (gw + 3 * ngw / 4) % ngw, ngw, lane);
    transpose_w(tile, p.w_uq, 256, 768, p.q_a_norm_w, (bf16_t*)(ws + WS_WUQ), 768, 256, MapUq(), (gw + 7 * ngw / 8) % ngw, ngw, lane);
    transpose_w(tile, p.w_ukv, 128, 1024, p.kv_a_norm_w, (bf16_t*)(ws + WS_WUKV), 1024, 128, MapId(), (gw + 15 * ngw / 16) % ngw, ngw, lane);
    bf16_t* xb = (bf16_t*)(ws + WS_XB); float* rstd1 = (float*)(ws + WS_RSTD1);
    for (int row0 = (bid * 8 + wave) * 4; row0 < M_TOK; row0 += nb * 32) { f32x4 v[4][4]; float ss[4] = {0.f, 0.f, 0.f, 0.f};
#pragma unroll
        for (int q = 0; q < 4; ++q) { const f32x4* xr = (const f32x4*)(p.x + (size_t)(row0 + q) * 1024);
#pragma unroll
            for (int i = 0; i < 4; ++i) v[q][i] = __builtin_nontemporal_load(xr + lane + 64 * i); }
#pragma unroll
        for (int q = 0; q < 4; ++q) {
#pragma unroll
            for (int i = 0; i < 4; ++i) ss[q] += (v[q][i][0] * v[q][i][0] + v[q][i][1] * v[q][i][1]) + (v[q][i][2] * v[q][i][2] + v[q][i][3] * v[q][i][3]);
#pragma unroll
            for (int i = 0; i < 4; ++i) { u32x2 w; w.x = cvt_pk_bf16(v[q][i][0], v[q][i][1]); w.y = cvt_pk_bf16(v[q][i][2], v[q][i][3]); *(u32x2*)(xb + (size_t)(row0 + q) * 1024 + (lane + 64 * i) * 4) = w; } }
#pragma unroll
        for (int q = 0; q < 4; ++q) ss[q] = wave_sum(ss[q], lane);
        if (lane < 4) rstd1[row0 + lane] = rsqrtf((lane == 0 ? ss[0] : lane == 1 ? ss[1] : lane == 2 ? ss[2] : ss[3]) * (1.f / 1024.f) + EPS); }
    { float* ssum2 = (float*)(ws + WS_SSUM2); for (int i = bid * 512 + tid; i < M_TOK; i += nb * 512) ssum2[i] = 0.f; }
    float* cs = (float*)(ws + WS_ROPE); float* sn = cs + SEQ * 32;
    for (int idx = bid * 512 + tid; idx < SEQ * 32; idx += nb * 512) { const int pos = idx >> 5, i = idx & 31;
        const float inv = exp2f(-(float)i * (13.287712379549449f / 32.f)); const float ang = (float)pos * inv;
        const double rev = (double)ang * 0.15915494309189535; const float fr = (float)(rev - rint(rev));
        cs[idx] = __builtin_amdgcn_cosf(fr); sn[idx] = __builtin_amdgcn_sinf(fr); }
    if (bid == 0 && wave == 0) { const float d1 = wave_sum(p.lambda_q1[lane] * p.lambda_k1[lane], lane), d2 = wave_sum(p.lambda_q2[lane] * p.lambda_k2[lane], lane);
        if (lane == 0) ((float*)(ws + WS_MISC))[0] = expf(d1) - expf(d2) + 0.2f; }
}
DI void phase2(const Params& p, int wv) {
    int tid_ = fresh_tid<2>(wv); const int tid = tid_, bid = blockIdx.x, nb = gridDim.x, wave = tid >> 6, lane = tid & 63;
    unsigned char* ws = p.ws; bf16_t* P = (bf16_t*)(ws + WS_P); float* KR = (float*)(ws + WS_KR); float* rq = (float*)(ws + WS_RSTDQ); float* rkv = (float*)(ws + WS_RSTDKV); float* sskr_o = (float*)(ws + WS_SSKR);
    const float* cs = (const float*)(ws + WS_ROPE); const float* sn = cs + SEQ * 32;
    float gdq[8], gdk[8];
#pragma unroll
    for (int j = 0; j < 8; ++j) { gdq[j] = p.diff_q_norm_w[(lane & 7) * 8 + j] * (0.125f * LOG2E); gdk[j] = p.diff_k_norm_w[(lane & 7) * 8 + j]; }
    const int stride = nb * 8; int row = bid * 8 + wave;
    u32x2 cq_n; unsigned ckv_n; unsigned short kr_n; u32x4 dq_n, dk_n;
#define P2_LOAD(R) do { const bf16_t* pl_ = P + (size_t)(R) * 2048; cq_n = *(const u32x2*)(pl_ + lane * 4); ckv_n = *(const unsigned*)(pl_ + 256 + lane * 2); kr_n = pl_[384 + lane]; \
        dq_n = *(const u32x4*)(pl_ + 512 + lane * 8); dk_n = *(const u32x4*)(pl_ + 1024 + lane * 8); } while (0)
    if (row < M_TOK) P2_LOAD(row);
    for (; row < M_TOK; row += stride) { bf16_t* pr = P + (size_t)row * 2048;
        const u32x2 cq = cq_n; const unsigned ckv = ckv_n; const float kr = bf2f(kr_n); const u32x4 dq = dq_n, dk = dk_n;
        if (row + stride < M_TOK) P2_LOAD(row + stride);
        float a0 = __uint_as_float(cq.x << 16), a1 = __uint_as_float(cq.x & 0xffff0000u), a2 = __uint_as_float(cq.y << 16), a3 = __uint_as_float(cq.y & 0xffff0000u);
        float ssq = (a0 * a0 + a1 * a1) + (a2 * a2 + a3 * a3);
        float b0 = __uint_as_float(ckv << 16), b1 = __uint_as_float(ckv & 0xffff0000u); float sskv = b0 * b0 + b1 * b1;
        ssq = wave_sum(ssq, lane); sskv = wave_sum(sskv, lane); const float sskr = wave_sum(kr * kr, lane);
        const float partner = shx(kr, 32, lane); const int pos = row & (SEQ - 1), i = lane & 31; const float c = cs[pos * 32 + i], s = sn[pos * 32 + i];
        KR[(size_t)row * 64 + lane] = lane < 32 ? kr * c - partner * s : kr * c + partner * s;
        float fq_[8], fk_[8]; float sq = 0.f, sk = 0.f;
#pragma unroll
        for (int j = 0; j < 4; ++j) { fq_[2 * j] = __uint_as_float(dq[j] << 16); fq_[2 * j + 1] = __uint_as_float(dq[j] & 0xffff0000u); fk_[2 * j] = __uint_as_float(dk[j] << 16); fk_[2 * j + 1] = __uint_as_float(dk[j] & 0xffff0000u); }
#pragma unroll
        for (int j = 0; j < 8; ++j) { sq += fq_[j] * fq_[j]; sk += fk_[j] * fk_[j]; }
#pragma unroll
        for (int mk = 1; mk <= 4; mk <<= 1) { sq += shx(sq, mk, lane); sk += shx(sk, mk, lane); }
        const float rsq = rsqrtf(sq * (1.f / 64.f) + EPS), rsk = rsqrtf(sk * (1.f / 64.f) + EPS);
        u32x4 oq, ok;
#pragma unroll
        for (int j = 0; j < 4; ++j) { oq[j] = cvt_pk_bf16(fq_[2 * j] * rsq * gdq[2 * j], fq_[2 * j + 1] * rsq * gdq[2 * j + 1]); ok[j] = cvt_pk_bf16(fk_[2 * j] * rsk * gdk[2 * j], fk_[2 * j + 1] * rsk * gdk[2 * j + 1]); }
        *(u32x4*)(pr + 512 + lane * 8) = oq; *(u32x4*)(pr + 1024 + lane * 8) = ok;
        if (lane == 0) { rq[row] = rsqrtf(ssq * (1.f / 256.f) + EPS); rkv[row] = rsqrtf(sskv * (1.f / 128.f) + EPS); sskr_o[row] = sskr; } }
}
DI void phase3b(const Params& p, int wv) {
    int tid_ = fresh_tid<3>(wv); const int tid = tid_, bid = blockIdx.x, nb = gridDim.x, wave = tid >> 6, lane = tid & 63;
    unsigned char* ws = p.ws; bf16_t* KM = (bf16_t*)(ws + WS_KM); const float* KR = (const float*)(ws + WS_KR);
    const int hh = lane >> 4, d8 = (lane & 15) * 8; float g[8];
#pragma unroll
    for (int j = 0; j < 8; ++j) g[j] = p.mla_k_norm_w[d8 + j];
    const float gr = p.mla_k_norm_w[128 + lane];
    const int stride = nb * 8; int row = bid * 8 + wave; u32x4 kn_n; float r_n;
#define P3B_LOAD(R) do { kn_n = *(const u32x4*)(KM + (size_t)(R) * 768 + hh * 192 + d8); r_n = KR[(size_t)(R) * 64 + lane]; } while (0)
    if (row < M_TOK) P3B_LOAD(row);
    for (; row < M_TOK; row += stride) { bf16_t* kr_ = KM + (size_t)row * 768;
        const u32x4 kn = kn_n; const float r = r_n;
        if (row + stride < M_TOK) P3B_LOAD(row + stride);
        float f[8]; float ssn = 0.f;
#pragma unroll
        for (int j = 0; j < 4; ++j) { f[2 * j] = __uint_as_float(kn[j] << 16); f[2 * j + 1] = __uint_as_float(kn[j] & 0xffff0000u); }
#pragma unroll
        for (int j = 0; j < 8; ++j) ssn += f[j] * f[j];
#pragma unroll
        for (int mk = 1; mk <= 8; mk <<= 1) ssn += shx(ssn, mk, lane);
        const float ssr = wave_sum(r * r, lane);
        const float rstd = rsqrtf((ssn + ssr) * (1.f / 192.f) + EPS);
        u32x4 w;
#pragma unroll
        for (int j = 0; j < 4; ++j) w[j] = cvt_pk_bf16(f[2 * j] * rstd * g[2 * j], f[2 * j + 1] * rstd * g[2 * j + 1]);
        *(u32x4*)(kr_ + hh * 192 + d8) = w;
#pragma unroll
        for (int h2 = 0; h2 < 4; ++h2) { const float rh = shl_from(rstd, h2 * 16); kr_[h2 * 192 + 128 + lane] = f2bf(r * rh * gr); } }
}
DI void phase4(const Params& p, LAS unsigned char* lds, int wv) {
    unsigned char* ws = p.ws;
    const bf16_t* P = (const bf16_t*)(ws + WS_P); const bf16_t* Q = (const bf16_t*)(ws + WS_Q); const bf16_t* KM = (const bf16_t*)(ws + WS_KM); const bf16_t* V = (const bf16_t*)(ws + WS_V);
    bf16_t* AO = (bf16_t*)(ws + WS_AO); float* S0 = (float*)(ws + WS_S0); const float lam = ((const float*)(ws + WS_MISC))[0];
    for (int L = blockIdx.x; L < 2048; L += gridDim.x) {
        const int i = L >> 8, c = L & 255, x = c & 7, j = c >> 3, g = i * 8 + x, b = g >> 2, h = g & 3, kind = ((j >> 4) + i) & 1, qb = j & 15;
        const size_t rowbase = (size_t)b * SEQ, qrow = rowbase + qb * 256;
        if (kind == 0) {
            att::attn_body<192, 0, 768, 768, 512>(Q + qrow * 768 + h * 192, KM + rowbase * 768 + h * 192, V + rowbase * 512 + h * 128, qb * 256, 0.07216878364870322f * LOG2E,
                                                 p.mla_q_norm_w, nullptr, AO + qrow * 1024 + h * 128, 0.f, nullptr, lds, wv);
            __syncthreads();
        } else {
            LAS float* bt = (LAS float*)(lds + att::BT_OFF);
            const int tid = fresh_tid<4>(wv);
            if (tid < 449) { const int rel = tid - 224, n = rel < 0 ? -rel : rel;
                int lg = 8 + (n >= 12) + (n >= 16) + (n >= 23) + (n >= 32) + (n >= 46) + (n >= 64) + (n >= 91); const int bucket = (rel > 0 ? 16 : 0) + (n < 8 ? n : lg);
                bt[tid] = p.rel_bias[bucket * 4 + h] * LOG2E; }
            __syncthreads();
            att::attn_body<64, 1, 2048, 2048, 2048>(P + qrow * 2048 + 512 + h * 128, P + rowbase * 2048 + 1024 + h * 128, P + rowbase * 2048 + 1536 + h * 128, qb * 256, 0.f,
                                                   nullptr, S0 + qrow * 512 + h * 128, nullptr, 0.f, nullptr, lds, wv);
            __syncthreads();
            att::attn_body<64, 2, 2048, 2048, 2048>(P + qrow * 2048 + 512 + h * 128 + 64, P + rowbase * 2048 + 1024 + h * 128 + 64, P + rowbase * 2048 + 1536 + h * 128, qb * 256, 0.f,
                                                   nullptr, S0 + qrow * 512 + h * 128, AO + qrow * 1024 + 512 + h * 128, lam, p.diff_out_norm_w, lds, wv);
            __syncthreads();
        }
    }
}

constexpr int LDS_BYTES = 148 * 1024;
static_assert(att::ATT_LDS <= LDS_BYTES && pg8::STAGE_BYTES <= LDS_BYTES, "LDS must fit");
template <class Epi> DI void run_gemm(LAS unsigned char* lds, int wv, const bf16_t* A, int lda, const bf16_t* Bt, int N, int K, const Epi& E) {
    if (K <= 256) asm volatile("" : "+s"(K), "+s"(N), "+s"(lda));
    pg8::Gemm g{A, Bt, M_TOK, N, K, lda}; pg8::StaticOrder S; S.init(M_TOK, N, (int)gridDim.x, (int)blockIdx.x);
    pg8::gemm_phase<Epi, pg8::StaticOrder, true, true>(lds, g, S, E, wv);
}
template <int TAG> DI void fast_grid_sync(unsigned* cnt, int wv) {
    __syncthreads();
    if (wv == 0) {
        __builtin_amdgcn_fence(__ATOMIC_RELEASE, "agent");
        if ((fresh_tid<200 + TAG>(wv) & 63) == 0) {
            const unsigned G = gridDim.x, g = blockIdx.x & 7u, members = (G - g + 7u) >> 3, ngroups = G < 8u ? G : 8u;
            if (__hip_atomic_fetch_add(cnt + g * 32, 1u, __ATOMIC_RELAXED, __HIP_MEMORY_SCOPE_AGENT) == members - 1u)
                __hip_atomic_fetch_add(cnt + 8 * 32, 1u, __ATOMIC_RELAXED, __HIP_MEMORY_SCOPE_AGENT);
            while (__hip_atomic_load(cnt + 8 * 32, __ATOMIC_RELAXED, __HIP_MEMORY_SCOPE_AGENT) < ngroups) __builtin_amdgcn_s_sleep(1);
        }
        __builtin_amdgcn_fence(__ATOMIC_ACQUIRE, "agent");
    }
    __syncthreads();
}
__global__ void __launch_bounds__(512) fwd_kernel(Params p) {
    extern __shared__ __attribute__((aligned(16))) unsigned char lds_raw[];
    LAS unsigned char* lds = (LAS unsigned char*)lds_raw;
    cg::grid_group grid = cg::this_grid();
    const int wv = __builtin_amdgcn_readfirstlane(threadIdx.x >> 6);
    unsigned char* ws = p.ws; unsigned* bar = (unsigned*)(ws + WS_BAR);
    bf16_t* XB = (bf16_t*)(ws + WS_XB); bf16_t* P = (bf16_t*)(ws + WS_P); bf16_t* Q = (bf16_t*)(ws + WS_Q); bf16_t* KM = (bf16_t*)(ws + WS_KM); bf16_t* V = (bf16_t*)(ws + WS_V);
    bf16_t* U = (bf16_t*)(ws + WS_U); bf16_t* AO = (bf16_t*)(ws + WS_AO);
    float* ssq2 = (float*)(ws + WS_SSQ2); const float* cs = (const float*)(ws + WS_ROPE);
    phase0(p, lds, wv);
    fast_grid_sync<1>(bar + 2560, wv);
    if (p.ws == nullptr) grid.sync();
    { EpiProj E{P, (const float*)(ws + WS_RSTD1), (float*)(ws + WS_SSQ4), (float*)(ws + WS_SSKV4), (float*)(ws + WS_SSKR2), (float*)(ws + WS_KR), cs, cs + SEQ * 32, p.diff_q_norm_w, p.diff_k_norm_w}; run_gemm(lds, wv, XB, 1024, (const bf16_t*)(ws + WS_WIN), 2048, 1024, E); }
    fast_grid_sync<2>(bar + 0, wv);
    { EpiQ E{Q, (const float*)(ws + WS_SSQ4), cs, cs + SEQ * 32}; run_gemm(lds, wv, P, 2048, (const bf16_t*)(ws + WS_WUQ), 768, 256, E); }
    { EpiKV E{KM, V, (const float*)(ws + WS_SSKV4), (const float*)(ws + WS_KR), (const float*)(ws + WS_SSKR2), p.mla_k_norm_w, (LAS float*)(lds + pg8::STAGE_BYTES)}; run_gemm(lds, wv, P + 256, 2048, (const bf16_t*)(ws + WS_WUKV), 1024, 128, E); }
    fast_grid_sync<3>(bar + 512, wv);
    phase4(p, lds, wv);
    fast_grid_sync<4>(bar + 1024, wv);
    { EpiOut E{XB, (float*)(ws + WS_SSUM2)}; run_gemm(lds, wv, AO, 1024, (const bf16_t*)(ws + WS_WOUT), 1024, 1024, E); }
    fast_grid_sync<5>(bar + 1536, wv);
    { EpiUp E{U, (const float*)(ws + WS_SSUM2)}; run_gemm(lds, wv, XB, 1024, (const bf16_t*)(ws + WS_WUP), 4096, 1024, E); }
    fast_grid_sync<6>(bar + 2048, wv);
    { EpiDown E{p.out, XB}; run_gemm(lds, wv, U, 4096, (const bf16_t*)(ws + WS_WDN), 1024, 4096, E); }
}

extern "C" void kernel_launch(void* const* d_in, const int* in_sizes, int n_in, void* d_out, int out_size, void* d_ws, size_t ws_size, hipStream_t stream) {
    static int grid_blocks = 0;
    if (grid_blocks == 0) {
        if (n_in != 21 || in_sizes[0] != M_TOK * 1024 || out_size != M_TOK * 1024 || ws_size < WS_END) { fprintf(stderr, "kernel_launch: unexpected shapes (n_in %d, in0 %d, out %d, ws %zu)\n", n_in, n_in > 0 ? in_sizes[0] : -1, out_size, ws_size); grid_blocks = -1; return; }
        int dev = 0, cus = 0, per_cu = 0;
        hipGetDevice(&dev); hipDeviceGetAttribute(&cus, hipDeviceAttributeMultiprocessorCount, dev);
        if (hipFuncSetAttribute((const void*)fwd_kernel, hipFuncAttributeMaxDynamicSharedMemorySize, LDS_BYTES) != hipSuccess) { fprintf(stderr, "kernel_launch: hipFuncSetAttribute failed\n"); grid_blocks = -1; return; }
        if (hipOccupancyMaxActiveBlocksPerMultiprocessor(&per_cu, (const void*)fwd_kernel, 512, LDS_BYTES) != hipSuccess || per_cu < 1) { fprintf(stderr, "kernel_launch: occupancy query says %d\n", per_cu); per_cu = 1; }
        (void)hipGetLastError();
        grid_blocks = cus * 1;
    }
    if (grid_blocks < 0) return;
    Params p{};
    const float** pp = (const float**)&p;
    for (int i = 0; i < 21; ++i) pp[i] = (const float*)d_in[i];
    p.out = (float*)d_out; p.ws = (unsigned char*)d_ws;
    if (hipMemsetAsync((unsigned char*)d_ws + WS_BAR, 0, 16384, stream) != hipSuccess) { fprintf(stderr, "kernel_launch: hipMemsetAsync failed\n"); return; }
    void* args[] = {&p};
    hipError_t e = hipLaunchCooperativeKernel((const void*)fwd_kernel, dim3(grid_blocks), dim3(512), args, LDS_BYTES, stream);
    if (e != hipSuccess) fprintf(stderr, "cooperative launch failed: %s (grid %d)\n", hipGetErrorString(e), grid_blocks);
}
```
